# Optimizing an MI355X kernel written in HIP

```python
import math
import jax, jax.numpy as jnp
from jax import lax
import numpy as np

D_MODEL = 2048
BATCH = 16
SEQ = 2048
DEPTH = 2

GM_GROUPS = 4
GM_CH = 256
GM_WIDTH = GM_GROUPS * GM_CH
CHUNK = 128
DA_HEADS = 8
DA_HEAD_DIM = 64
DA_V_DIM = 2 * DA_HEAD_DIM
DA_QK_WIDTH = DA_HEADS * 2 * DA_HEAD_DIM
DA_WIDTH = DA_HEADS * DA_V_DIM
MIX_IN = 2 * GM_WIDTH + 2 * DA_QK_WIDTH + DA_WIDTH
MIX_OUT = GM_WIDTH + DA_WIDTH
Q_BLOCK = 128
S5_GROUP = 16
S5_GROUPS = D_MODEL // S5_GROUP
S5_STATE = 64
D_FF = 5632
N_EXPERTS = 8
TOP_K = 2
D_FF_EXPERT = 7168
N_EVEN = (DEPTH + 1) // 2
N_ODD = DEPTH // 2
EPS = 1e-6

kernel_name = "hybrid_gmlp_diffattn_s5_moe_encoder"


def rmsnorm(x, g):
    xf = x.astype(jnp.float32)
    y = xf * lax.rsqrt(jnp.mean(xf * xf, axis=-1, keepdims=True) + EPS)
    return (y * g.astype(jnp.float32)).astype(x.dtype)


def swiglu(x, w_gu, w_down):
    gate, up = jnp.split(jnp.einsum('...d,df->...f', x, w_gu), 2, axis=-1)
    return jnp.einsum('...f,fd->...d', jax.nn.silu(gate) * up, w_down)


def spatial_gating(u, v, gm_norm, ws, bs):
    b, s = u.shape[:2]
    v = rmsnorm(v, gm_norm)
    vc = v.reshape(b, s // CHUNK, CHUNK, GM_GROUPS, GM_CH)
    mixed = jnp.einsum('gts,bnsgc->bntgc', ws, vc) + bs.T[None, None, :, :, None]
    return (u * mixed.reshape(b, s, GM_GROUPS, GM_CH)).reshape(b, s, GM_WIDTH)


def diff_attention(q, k, v, lam, subln_g, lam_init):
    b, s = q.shape[:2]
    nb = s // Q_BLOCK
    slopes = 2.0 ** (-8.0 * jnp.arange(1, DA_HEADS + 1, dtype=jnp.float32) / DA_HEADS)
    kpos = jnp.arange(s, dtype=jnp.float32)
    scale = DA_HEAD_DIM ** -0.5
    qb = q.reshape(b, nb, Q_BLOCK, DA_HEADS, 2, DA_HEAD_DIM).transpose(1, 0, 2, 3, 4, 5)

    def block(args):
        qi, i = args
        qpos = (i * Q_BLOCK + jnp.arange(Q_BLOCK)).astype(jnp.float32)
        dist = jnp.abs(qpos[:, None] - kpos[None, :])
        logits = jnp.einsum('bqhid,bkhid->bhiqk', qi, k).astype(jnp.float32) * scale
        logits = logits - slopes[None, :, None, None, None] * dist
        p = jax.nn.softmax(logits, axis=-1)
        attn = p[:, :, 0] - lam * p[:, :, 1]
        return jnp.einsum('bhqk,bkhe->bqhe', attn.astype(v.dtype), v)

    out = lax.map(block, (qb, jnp.arange(nb)))
    out = out.transpose(1, 0, 2, 3, 4).reshape(b, s, DA_HEADS, DA_V_DIM)
    out = rmsnorm(out, subln_g) * (1.0 - lam_init)
    return out.reshape(b, s, DA_WIDTH)


def s5_bidirectional(u, lam_re, lam_im, log_dt, b_re, b_im, c_re, c_im, d_skip):
    b, s, _ = u.shape
    f32 = jnp.float32
    lam = lax.complex(lam_re.astype(f32), lam_im.astype(f32))
    dt = jnp.exp(log_dt.astype(f32))[..., None]
    lam_bar = jnp.exp(lam * dt)
    b_mat = lax.complex(b_re.astype(f32), b_im.astype(f32))
    b_bar = ((lam_bar - 1.0) / lam)[..., None] * b_mat
    c_mat = lax.complex(c_re.astype(f32), c_im.astype(f32))
    d_g = d_skip.astype(f32).reshape(S5_GROUPS, S5_GROUP)

    def combine(e1, e2):
        a1, x1 = e1
        a2, x2 = e2
        return a2 * a1, a2 * x1 + x2

    def one_sequence(us):
        uf = us.astype(f32)
        uc = uf.astype(jnp.complex64)
        y = uf * d_g
        for direction, reverse in ((0, False), (1, True)):
            bu = jnp.einsum('sgc,gpc->sgp', uc, b_bar[direction])
            a = jnp.broadcast_to(lam_bar[direction], bu.shape)
            _, states = lax.associative_scan(combine, (a, bu), axis=0, reverse=reverse)
            y = y + jnp.einsum('sgp,gcp->sgc', states, c_mat[direction]).real
        return y

    ys = lax.map(one_sequence, u.reshape(b, s, S5_GROUPS, S5_GROUP))
    return ys.reshape(b, s, D_MODEL).astype(u.dtype)


def moe_swiglu(h, router_w, w_gu, w_down):
    b, s, d = h.shape
    t = h.reshape(b * s, d)
    logits = jnp.einsum('nd,de->ne', t, router_w).astype(jnp.float32)
    top_val, top_idx = lax.top_k(logits, TOP_K)
    gates = jax.nn.softmax(top_val, axis=-1)
    combine_w = jnp.sum(jax.nn.one_hot(top_idx, N_EXPERTS, dtype=jnp.float32) * gates[..., None], axis=1)
    out = jnp.zeros_like(t)
    for e in range(N_EXPERTS):
        out = out + combine_w[:, e:e + 1].astype(t.dtype) * swiglu(t, w_gu[e], w_down[e])
    return out.reshape(b, s, d)


def setup_inputs(seed: int = 0) -> dict:
    key = jax.random.key(seed)
    ks = iter(jax.random.split(key, 40))

    def nrm(shape, scale):
        return jax.random.normal(next(ks), shape, jnp.float32) * scale

    def gain(shape):
        return 1.0 + nrm(shape, 0.05)

    D = D_MODEL
    G5, P, C = S5_GROUPS, S5_STATE, S5_GROUP
    n_idx = jnp.arange(P, dtype=jnp.float32)
    return {
        "x": nrm((BATCH, SEQ, D), 1.0),
        "mix_norm_even": gain((N_EVEN, D)),
        "w_in": nrm((N_EVEN, D, MIX_IN), D ** -0.5),
        "gm_norm": gain((N_EVEN, GM_GROUPS, GM_CH)),
        "gm_ws": nrm((N_EVEN, GM_GROUPS, CHUNK, CHUNK), CHUNK ** -0.5),
        "gm_bs": 1.0 + nrm((N_EVEN, GM_GROUPS, CHUNK), 0.1),
        "lam_q1": nrm((N_EVEN, DA_HEAD_DIM), 0.1),
        "lam_k1": nrm((N_EVEN, DA_HEAD_DIM), 0.1),
        "lam_q2": nrm((N_EVEN, DA_HEAD_DIM), 0.1),
        "lam_k2": nrm((N_EVEN, DA_HEAD_DIM), 0.1),
        "da_subln": gain((N_EVEN, DA_V_DIM)),
        "w_out": nrm((N_EVEN, MIX_OUT, D), MIX_OUT ** -0.5),
        "ffn_norm_even": gain((N_EVEN, D)),
        "ffn_w_gu": nrm((N_EVEN, D, 2 * D_FF), D ** -0.5),
        "ffn_w_down": nrm((N_EVEN, D_FF, D), D_FF ** -0.5),
        "mix_norm_odd": gain((N_ODD, D)),
        "s5_lam_re": -0.5 + nrm((N_ODD, 2, G5, P), 0.01),
        "s5_lam_im": math.pi * n_idx + nrm((N_ODD, 2, G5, P), 0.01),
        "s5_log_dt": jax.random.uniform(next(ks), (N_ODD, 2, G5), jnp.float32,
                                        minval=math.log(1e-3), maxval=math.log(1e-1)),
        "s5_b_re": nrm((N_ODD, 2, G5, P, C), (2.0 * C) ** -0.5),
        "s5_b_im": nrm((N_ODD, 2, G5, P, C), (2.0 * C) ** -0.5),
        "s5_c_re": nrm((N_ODD, 2, G5, C, P), 0.5),
        "s5_c_im": nrm((N_ODD, 2, G5, C, P), 0.5),
        "s5_d": nrm((N_ODD, D), 1.0),
        "glu_w": nrm((N_ODD, D, 2 * D), D ** -0.5),
        "moe_norm": gain((N_ODD, D)),
        "router_w": nrm((N_ODD, D, N_EXPERTS), D ** -0.5),
        "exp_w_gu": nrm((N_ODD, N_EXPERTS, D, 2 * D_FF_EXPERT), D ** -0.5),
        "exp_w_down": nrm((N_ODD, N_EXPERTS, D_FF_EXPERT, D), D_FF_EXPERT ** -0.5),
        "final_norm": gain((D,)),
    }


def reference(x, mix_norm_even, w_in, gm_norm, gm_ws, gm_bs, lam_q1, lam_k1, lam_q2, lam_k2,
              da_subln, w_out, ffn_norm_even, ffn_w_gu, ffn_w_down,
              mix_norm_odd, s5_lam_re, s5_lam_im, s5_log_dt, s5_b_re, s5_b_im, s5_c_re, s5_c_im,
              s5_d, glu_w, moe_norm, router_w, exp_w_gu, exp_w_down, final_norm):
    b, s, _ = x.shape
    h = x
    for layer in range(DEPTH):
        i = layer // 2
        if layer % 2 == 0:
            hn = rmsnorm(h, mix_norm_even[i])
            proj = jnp.einsum('bsd,df->bsf', hn, w_in[i])
            gm_u, gm_v, da_q, da_k, da_v = jnp.split(
                proj, [GM_WIDTH, 2 * GM_WIDTH, 2 * GM_WIDTH + DA_QK_WIDTH,
                       2 * GM_WIDTH + 2 * DA_QK_WIDTH], axis=-1)
            gm_u = jax.nn.gelu(gm_u).reshape(b, s, GM_GROUPS, GM_CH)
            gm_v = jax.nn.gelu(gm_v).reshape(b, s, GM_GROUPS, GM_CH)
            out_a = spatial_gating(gm_u, gm_v, gm_norm[i], gm_ws[i], gm_bs[i])

            lam_init = 0.8 - 0.6 * math.exp(-0.3 * layer)
            lam = (jnp.exp(jnp.sum(lam_q1[i].astype(jnp.float32) * lam_k1[i].astype(jnp.float32)))
                   - jnp.exp(jnp.sum(lam_q2[i].astype(jnp.float32) * lam_k2[i].astype(jnp.float32)))
                   + lam_init)
            q = da_q.reshape(b, s, DA_HEADS, 2, DA_HEAD_DIM)
            k = da_k.reshape(b, s, DA_HEADS, 2, DA_HEAD_DIM)
            v = da_v.reshape(b, s, DA_HEADS, DA_V_DIM)
            out_b = diff_attention(q, k, v, lam, da_subln[i], lam_init)

            mixed = jnp.concatenate([out_a, out_b], axis=-1)
            h = h + jnp.einsum('bsf,fd->bsd', mixed, w_out[i])
            h = h + swiglu(rmsnorm(h, ffn_norm_even[i]), ffn_w_gu[i], ffn_w_down[i])
        else:
            hn = rmsnorm(h, mix_norm_odd[i])
            y = s5_bidirectional(hn, s5_lam_re[i], s5_lam_im[i], s5_log_dt[i], s5_b_re[i],
                                 s5_b_im[i], s5_c_re[i], s5_c_im[i], s5_d[i])
            val, gate = jnp.split(jnp.einsum('bsd,df->bsf', jax.nn.gelu(y), glu_w[i]), 2, axis=-1)
            h = h + val * jax.nn.sigmoid(gate)
            h = h + moe_swiglu(rmsnorm(h, moe_norm[i]), router_w[i], exp_w_gu[i], exp_w_down[i])
    return rmsnorm(h, final_norm)
```

```cpp
#include <hip/hip_runtime.h>
#include <cstdio>
#include <cstdint>

#ifndef MK_MULTI
#define MK_MULTI 0
#endif

#define LAS __attribute__((address_space(3)))
typedef unsigned short bf16_t;
typedef short bf16x8 __attribute__((ext_vector_type(8)));
typedef short s16x4 __attribute__((ext_vector_type(4)));
typedef float f32x2 __attribute__((ext_vector_type(2)));
typedef float f32x4 __attribute__((ext_vector_type(4)));
typedef float f32x16 __attribute__((ext_vector_type(16)));
typedef unsigned u32x2 __attribute__((ext_vector_type(2)));
typedef unsigned u32x4 __attribute__((ext_vector_type(4)));
typedef __bf16 bf16x2_t __attribute__((ext_vector_type(2)));
typedef int i32x4 __attribute__((ext_vector_type(4)));
typedef int i32x8 __attribute__((ext_vector_type(8)));
typedef unsigned u32x6 __attribute__((ext_vector_type(6)));

__device__ __forceinline__ unsigned pk2(float lo, float hi) { f32x2 v = {lo, hi}; bf16x2_t b = __builtin_convertvector(v, bf16x2_t); return __builtin_bit_cast(unsigned, b); }
__device__ __forceinline__ unsigned pk4_fp8(float a, float b, float c, float d) { int r = __builtin_amdgcn_cvt_pk_fp8_f32(a, b, 0, false); r = __builtin_amdgcn_cvt_pk_fp8_f32(c, d, r, true); return (unsigned)r; }
__device__ __forceinline__ void quant_fp6_block(const float (&x)[32], u32x6& pack, unsigned& sb) {
    float amax = 0.f;
#pragma unroll
    for (int i = 0; i < 32; ++i) amax = fmaxf(amax, fabsf(x[i]));
    int e = (int)((__float_as_uint(amax) >> 23) & 0xffu) - 2; e = e < 0 ? 0 : e;
    const float inv = __uint_as_float((unsigned)(254 - e) << 23);
    f32x16 lo, hi;
#pragma unroll
    for (int i = 0; i < 16; ++i) { lo[i] = x[i] * inv; hi[i] = x[16 + i] * inv; }
    pack = __builtin_bit_cast(u32x6, __builtin_amdgcn_cvt_scalef32_2xpk16_fp6_f32(lo, hi, 1.0f));
    sb = (unsigned)e;
}
__device__ __forceinline__ float bf2f(unsigned short b) { return __uint_as_float(((unsigned)b) << 16); }
__device__ __forceinline__ float bflo(unsigned w) { return __uint_as_float(w << 16); }
__device__ __forceinline__ float bfhi(unsigned w) { return __uint_as_float(w & 0xffff0000u); }
__device__ __forceinline__ float fast_sigmoid(float x) { return __builtin_amdgcn_rcpf(1.f + __builtin_amdgcn_exp2f(-1.4426950408889634f * x)); }
__device__ __forceinline__ float gelu_tanh(float x) { const float t = x * x, p = t * -0.1029432410f + -2.3022082f; return x * __builtin_amdgcn_rcpf(1.f + __builtin_amdgcn_exp2f(x * p)); }
__device__ __forceinline__ float silu_f(float x) { return x * fast_sigmoid(x); }
__device__ __forceinline__ f32x2 swiglu2(f32x2 g, f32x2 u, float ka, float c) {
    const f32x2 x = g * u, ea = g * ka; f32x2 e; e.x = __builtin_amdgcn_exp2f(ea.x); e.y = __builtin_amdgcn_exp2f(ea.y);
    const f32x2 d = e * c + c; f32x2 r; r.x = __builtin_amdgcn_rcpf(d.x); r.y = __builtin_amdgcn_rcpf(d.y);
    return x * r;
}
__device__ __forceinline__ int lane_id_v() { int l; asm volatile("v_mbcnt_lo_u32_b32 %0, -1, 0\n\tv_mbcnt_hi_u32_b32 %0, -1, %0" : "=v"(l)); return l; }
template <int M> __device__ __forceinline__ float swz_xor(float v) { return __int_as_float(__builtin_amdgcn_ds_swizzle(__float_as_int(v), 0x1F | (M << 10))); }
__device__ __forceinline__ float half_sum(float v) { auto rr = __builtin_amdgcn_permlane32_swap(__float_as_uint(v), __float_as_uint(v), false, false); return __uint_as_float(rr[0]) + __uint_as_float(rr[1]); }
__device__ __forceinline__ float half_max(float v) { auto rr = __builtin_amdgcn_permlane32_swap(__float_as_uint(v), __float_as_uint(v), false, false); return fmaxf(__uint_as_float(rr[0]), __uint_as_float(rr[1])); }
__device__ __forceinline__ float wave_sum(float v) {
    v += swz_xor<1>(v); v += swz_xor<2>(v); v += swz_xor<4>(v); v += swz_xor<8>(v); v += swz_xor<16>(v);
    return half_sum(v);
}

constexpr int DM = 2048, NB = 16, SEQ = 2048, M = NB * SEQ;
constexpr int MIX_IN = 5120, DFF = 5632, NEXP = 8, DFE = 7168;
constexpr int S5G = 128, S5L = 32, S5ROWS = S5G * 1024, S5K = 768;
constexpr int MOE_ROWS = 2 * M + NEXP * 256;
constexpr float EPS = 1e-6f;
constexpr float Y8_SCALE = 8.f;
constexpr float A8_FFN_SCALE = 8.f;
constexpr float W8_GU_SCALE = 64.f, W8_DN_SCALE = 128.f;
constexpr float QSCALE = 0.125f * 1.4426950408889634f;

constexpr size_t MiB = (size_t)1 << 20;
constexpr size_t WS_CTL = 0, CTL_ZERO_BYTES = 1 * MiB;
constexpr size_t WS_ROUTE = 1 * MiB;
constexpr size_t WS_GMWS = 2 * MiB;
constexpr size_t WS_SL = 3 * MiB;
constexpr size_t WS_WIN = 8 * MiB;
constexpr size_t WS_WOUT = WS_WIN + 20 * MiB;
constexpr size_t WS_WGU = WS_WOUT + 8 * MiB;
constexpr size_t WS_WDN = WS_WGU + 44 * MiB;
constexpr size_t WS_WGLU = WS_WDN + 22 * MiB;
constexpr size_t WS_WEGU = WS_WGLU + 16 * MiB;
constexpr size_t WS_WEDN = WS_WEGU + 448 * MiB;
constexpr size_t WS_S5BY = WS_WEDN + 224 * MiB;
constexpr size_t WS_S5BZ = WS_S5BY + 96 * MiB;
constexpr size_t WS_ACT0 = WS_S5BZ + 32 * MiB;
constexpr size_t WS_HN = WS_ACT0;
constexpr size_t WS_PROJ = WS_HN + 128 * MiB;
constexpr size_t WS_O0 = WS_PROJ + 320 * MiB;
constexpr size_t WS_MIXED = WS_O0 + 128 * MiB;
constexpr size_t WS_ACT = WS_PROJ;
constexpr size_t WS_UA = WS_HN + 128 * MiB;
constexpr size_t WS_Z = WS_UA + 192 * MiB;
constexpr size_t WS_YG = WS_Z + 128 * MiB;
constexpr size_t WS_HN2 = WS_YG + 128 * MiB;
constexpr size_t WS_XP = WS_HN2 + 128 * MiB;
constexpr size_t WS_ACTM = WS_XP + 264 * MiB;
constexpr size_t WS_YP = WS_UA;
constexpr size_t WS_END = WS_ACTM + 924 * MiB;
constexpr int CW_BAR = 4096;
constexpr int CW_ECNT = 16384;
constexpr int CW_EFILL = 16384 + 1024;

constexpr int SCR_BYTES = 155648;
constexpr int LDSCTL_OFF = SCR_BYTES;
constexpr int LDS_BYTES = 159744;

namespace pg8 {
constexpr int BM = 256, BK = 64, HALF = 128, HTB = HALF * BK * 2, STAGE_BYTES = 8 * HTB, NXCD = 8, WGM = 8;
__host__ __device__ __forceinline__ int lds_byte(int r, int c) { const int st = (r >> 4) * 2 + (c >> 5), rr = r & 15, cc = c & 31, ob = rr * 64 + cc * 2; return st * 1024 + (ob ^ (((ob >> 9) & 1) << 5)); }
__host__ __device__ __forceinline__ void stage_rc(int b, int& R, int& C) { const int st = b / 1024, sb = b % 1024, swz = sb ^ (((sb >> 9) & 1) << 5); R = (st >> 1) * 16 + swz / 64; C = (st & 1) * 32 + (swz % 64) / 2; }
__host__ __device__ __forceinline__ int perm32(int rho) { const int n = rho >> 4, i = rho & 15; return 8 * (i >> 2) + 4 * n + (i & 3); }

struct Unit { int pm, pn; };
struct Gemm { const bf16_t* A; const bf16_t* Bt; int lda, ldb, K; };

struct GridOrder {
    int nM, nN, nwg, G, c, rev;
    __device__ void init(int nM_, int nN_, int G_, int c_, int rev_ = 0) { nM = nM_; nN = nN_; nwg = nM * nN; G = G_; c = c_; rev = rev_; }
    __device__ __forceinline__ bool next(int i, Unit& u) const {
        const int ni = (nwg - c + G - 1) / G; if (i >= ni) return false;
        const long L = (long)(rev ? ni - 1 - i : i) * G + c;
        int wgid = (int)L; { const int q = nwg / NXCD, r = nwg % NXCD, xcd = wgid % NXCD, off = wgid / NXCD; wgid = (xcd < r ? xcd * (q + 1) : r * (q + 1) + (xcd - r) * q) + off; }
        const int nig = WGM * nN, gid = wgid / nig, fm = gid * WGM, gsz = (nM - fm) < WGM ? (nM - fm) : WGM;
        u.pm = fm + ((wgid % nig) % gsz); u.pn = (wgid % nig) / gsz; return true;
    }
    __device__ __forceinline__ void a_ready(const Unit&) const {}
    __device__ __forceinline__ void done(const Unit&) const {}
};
template <int RM, int RN> struct BatchOrder {
    int nwg, G, c;
    __device__ void init(int ngroups, int G_, int c_) { nwg = ngroups * RM * RN; G = G_; c = c_; }
    __device__ bool next(int i, Unit& u) const {
        const long L = (long)i * G + c; if (L >= nwg) return false;
        int wgid = (int)L; { const int q = nwg / NXCD, xcd = wgid % NXCD, off = wgid / NXCD; wgid = xcd * q + off; }
        const int g = wgid / (RM * RN), w = wgid % (RM * RN);
        u.pm = g * RM + (w % RM); u.pn = g * RN + (w / RM); return true;
    }
    __device__ __forceinline__ void a_ready(const Unit&) const {}
    __device__ __forceinline__ void done(const Unit&) const {}
};
struct ListOrder {
    int pm, pn0, n;
    __device__ bool next(int i, Unit& u) const { if (i >= n) return false; u.pm = pm; u.pn = pn0 + i; return true; }
    __device__ __forceinline__ void a_ready(const Unit&) const {}
    __device__ __forceinline__ void done(const Unit&) const {}
};
template <int NT> struct MoeOrder {
    GridOrder go; int ts[NEXP + 1];
    __device__ bool next(int i, Unit& u) const {
        if (!go.next(i, u)) return false;
        int e = 0;
#pragma unroll
        for (int k = 1; k < NEXP; ++k) e += (u.pm >= ts[k]) ? 1 : 0;
        u.pn += e * NT; return true;
    }
    __device__ __forceinline__ void a_ready(const Unit&) const {}
    __device__ __forceinline__ void done(const Unit&) const {}
};

struct EpiProj {
    static constexpr bool PERM = true; static constexpr int NVM = 16;
    bf16_t* O;
    __device__ __forceinline__ void operator()(const f32x4 (&acc)[2][2][4][2], const Unit& u, int wr, int wc, int fr, int fq) const {
        const int row0 = u.pm * BM + wr * 64 + fr, col0 = u.pn * BM + wc * 32 + 8 * fq;
        const int mode = (u.pn < 8) ? 1 : (u.pn < 12 ? 2 : 0);
#pragma unroll
        for (int ai = 0; ai < 2; ++ai)
#pragma unroll
            for (int m = 0; m < 4; ++m) { bf16_t* rowp = O + (size_t)(row0 + ai * HALF + m * 16) * MIX_IN + col0;
#pragma unroll
                for (int bj = 0; bj < 2; ++bj) { f32x4 v0 = acc[ai][bj][m][0], v1 = acc[ai][bj][m][1];
                    if (mode == 1) {
#pragma unroll
                        for (int j = 0; j < 4; ++j) { v0[j] = gelu_tanh(v0[j]); v1[j] = gelu_tanh(v1[j]); } }
                    else if (mode == 2) { v0 = v0 * QSCALE; v1 = v1 * QSCALE; }
                    u32x4 w; w.x = pk2(v0[0], v0[1]); w.y = pk2(v0[2], v0[3]); w.z = pk2(v1[0], v1[1]); w.w = pk2(v1[2], v1[3]);
                    *(u32x4*)(rowp + bj * HALF) = w; } }
    }
};
struct EpiResF32 {
    static constexpr bool PERM = false; static constexpr int NVM = 32;
    const float* res; float* out;
    __device__ __forceinline__ void operator()(const f32x4 (&acc)[2][2][4][2], const Unit& u, int wr, int wc, int fr, int fq) const {
        const int row0 = u.pm * BM + wr * 64 + fr, col0 = u.pn * BM + wc * 32 + 4 * fq;
        f32x4 r0[8], r1[8];
#define ER_OFF(G, mm) ((size_t)(row0 + ((G) >> 1) * HALF + (2 * ((G) & 1) + (mm)) * 16) * DM + col0)
#define ER_LOAD(G, R) do { _Pragma("unroll") for (int mm = 0; mm < 2; ++mm) _Pragma("unroll") for (int bj = 0; bj < 2; ++bj) _Pragma("unroll") for (int n = 0; n < 2; ++n) \
            R[mm * 4 + bj * 2 + n] = *(const f32x4*)(res + ER_OFF(G, mm) + bj * HALF + n * 16); } while (0)
#define ER_STORE(G, R) do { _Pragma("unroll") for (int mm = 0; mm < 2; ++mm) _Pragma("unroll") for (int bj = 0; bj < 2; ++bj) _Pragma("unroll") for (int n = 0; n < 2; ++n) \
            *(f32x4*)(out + ER_OFF(G, mm) + bj * HALF + n * 16) = R[mm * 4 + bj * 2 + n] + acc[(G) >> 1][bj][2 * ((G) & 1) + mm][n]; } while (0)
        ER_LOAD(0, r0); ER_LOAD(1, r1);
        ER_STORE(0, r0); ER_LOAD(2, r0);
        ER_STORE(1, r1); ER_LOAD(3, r1);
        ER_STORE(2, r0); ER_STORE(3, r1);
#undef ER_OFF
#undef ER_LOAD
#undef ER_STORE
    }
};
struct EpiResSq {
    static constexpr bool PERM = true; static constexpr int NVM = 32;
    const float* res; unsigned char* ws;
    __device__ __forceinline__ void operator()(const f32x4 (&acc)[2][2][4][2], const Unit& u, int wr, int wc, int fr, int fq) const {
        const int row0 = u.pm * BM + wr * 64 + fr, col0 = u.pn * BM + wc * 32 + 8 * fq;
        bf16_t* const hn = (bf16_t*)(ws + WS_HN); float* const sl = (float*)(ws + WS_SL);
        f32x4 r0[8], r1[8];
#define EQ_OFF(G, mm) ((size_t)(row0 + ((G) >> 1) * HALF + (2 * ((G) & 1) + (mm)) * 16) * DM + col0)
#define EQ_LOAD(G, R) do { _Pragma("unroll") for (int mm = 0; mm < 2; ++mm) _Pragma("unroll") for (int bj = 0; bj < 2; ++bj) _Pragma("unroll") for (int n = 0; n < 2; ++n) \
            R[mm * 4 + bj * 2 + n] = *(const f32x4*)(res + EQ_OFF(G, mm) + bj * HALF + n * 4); } while (0)
#define EQ_STORE(G, R) do { _Pragma("unroll") for (int mm = 0; mm < 2; ++mm) { float q_ = 0.f; _Pragma("unroll") for (int bj = 0; bj < 2; ++bj) { \
            const f32x4 o0 = R[mm * 4 + bj * 2] + acc[(G) >> 1][bj][2 * ((G) & 1) + mm][0], o1 = R[mm * 4 + bj * 2 + 1] + acc[(G) >> 1][bj][2 * ((G) & 1) + mm][1]; \
            u32x4 w; w.x = pk2(o0[0], o0[1]); w.y = pk2(o0[2], o0[3]); w.z = pk2(o1[0], o1[1]); w.w = pk2(o1[2], o1[3]); *(u32x4*)(hn + EQ_OFF(G, mm) + bj * HALF) = w; \
            q_ += ((o0[0] * o0[0] + o0[1] * o0[1]) + (o0[2] * o0[2] + o0[3] * o0[3])) + ((o1[0] * o1[0] + o1[1] * o1[1]) + (o1[2] * o1[2] + o1[3] * o1[3])); } \
            q_ += swz_xor<16>(q_); q_ = half_sum(q_);                                                          \
            if (fq == 0) sl[(size_t)(row0 + ((G) >> 1) * HALF + (2 * ((G) & 1) + mm) * 16) * 32 + u.pn * 4 + wc] = q_; } } while (0)
        EQ_LOAD(0, r0); EQ_LOAD(1, r1);
        EQ_STORE(0, r0); EQ_LOAD(2, r0);
        EQ_STORE(1, r1); EQ_LOAD(3, r1);
        EQ_STORE(2, r0); EQ_STORE(3, r1);
#undef EQ_LOAD
#undef EQ_STORE
#undef EQ_OFF
    }
};
struct EpiResBf {
    static constexpr bool PERM = true; static constexpr int NVM = 32;
    bf16_t* io; float s;
    __device__ __forceinline__ void operator()(const f32x4 (&acc)[2][2][4][2], const Unit& u, int wr, int wc, int fr, int fq) const {
        const int row0 = u.pm * BM + wr * 64 + fr, col0 = u.pn * BM + wc * 32 + 8 * fq;
        u32x4 r[16];
#pragma unroll
        for (int ai = 0; ai < 2; ++ai)
#pragma unroll
            for (int m = 0; m < 4; ++m)
#pragma unroll
                for (int bj = 0; bj < 2; ++bj) r[ai * 8 + m * 2 + bj] = *(const u32x4*)(io + (size_t)(row0 + ai * HALF + m * 16) * DM + col0 + bj * HALF);
#pragma unroll
        for (int ai = 0; ai < 2; ++ai)
#pragma unroll
            for (int m = 0; m < 4; ++m)
#pragma unroll
                for (int bj = 0; bj < 2; ++bj) { const u32x4 w = r[ai * 8 + m * 2 + bj]; bf16_t* op = io + (size_t)(row0 + ai * HALF + m * 16) * DM + col0 + bj * HALF;
                    const f32x4 a0 = acc[ai][bj][m][0] * s, a1 = acc[ai][bj][m][1] * s; u32x4 o;
                    o.x = pk2(a0[0] + bflo(w.x), a0[1] + bfhi(w.x)); o.y = pk2(a0[2] + bflo(w.y), a0[3] + bfhi(w.y));
                    o.z = pk2(a1[0] + bflo(w.z), a1[1] + bfhi(w.z)); o.w = pk2(a1[2] + bflo(w.w), a1[3] + bfhi(w.w));
                    *(u32x4*)op = o; }
    }
};
template <int NT> struct EpiSwiGLU {
    static constexpr bool PERM = true; static constexpr int NVM = 8;
    bf16_t* O; int ldo; const LAS float* rst; int pmA;
    __device__ __forceinline__ void operator()(const f32x4 (&acc)[2][2][4][2], const Unit& u, int wr, int wc, int fr, int fq) const {
        const int row0 = u.pm * BM + wr * 64 + fr, col0 = (u.pn % NT) * HALF + wc * 32 + 8 * fq;
        const LAS float* rt = rst + ((u.pm == pmA) ? 0 : 256) + wr * 64 + fr;
#pragma unroll
        for (int ai = 0; ai < 2; ++ai)
#pragma unroll
            for (int m = 0; m < 4; ++m) { bf16_t* rowp = O + (size_t)(row0 + ai * HALF + m * 16) * ldo + col0;
                const float rs = rt[ai * HALF + m * 16];
                const f32x4 g0 = acc[ai][0][m][0] * rs, g1 = acc[ai][0][m][1] * rs, u0 = acc[ai][1][m][0] * rs, u1 = acc[ai][1][m][1] * rs;
                const f32x2 a0 = swiglu2((f32x2){g0[0], g0[1]}, (f32x2){u0[0], u0[1]}, -1.4426950408889634f, 1.f), a1 = swiglu2((f32x2){g0[2], g0[3]}, (f32x2){u0[2], u0[3]}, -1.4426950408889634f, 1.f);
                const f32x2 a2 = swiglu2((f32x2){g1[0], g1[1]}, (f32x2){u1[0], u1[1]}, -1.4426950408889634f, 1.f), a3 = swiglu2((f32x2){g1[2], g1[3]}, (f32x2){u1[2], u1[3]}, -1.4426950408889634f, 1.f);
                u32x4 w; w.x = pk2(a0.x, a0.y); w.y = pk2(a1.x, a1.y); w.z = pk2(a2.x, a2.y); w.w = pk2(a3.x, a3.y);
                *(u32x4*)rowp = w; }
    }
};
template <int NT> struct EpiSwiGLUr8 {
    static constexpr bool PERM = true; static constexpr int NVM = 8;
    unsigned char* O; int ldo; const LAS float* rst; int pmA; float AS;
    __device__ __forceinline__ void operator()(const f32x4 (&acc)[2][2][4][2], const Unit& u, int wr, int wc, int fr, int fq) const {
        const int row0 = u.pm * BM + wr * 64 + fr, col0 = (u.pn % NT) * HALF + wc * 32 + 8 * fq;
        const LAS float* rt = rst + ((u.pm == pmA) ? 0 : 256) + wr * 64 + fr;
#pragma unroll
        for (int ai = 0; ai < 2; ++ai)
#pragma unroll
            for (int m = 0; m < 4; ++m) { unsigned char* rowp = O + (size_t)(row0 + ai * HALF + m * 16) * ldo + col0;
                const float rs = rt[ai * HALF + m * 16];
                const f32x4 g0 = acc[ai][0][m][0] * rs, g1 = acc[ai][0][m][1] * rs, u0 = acc[ai][1][m][0] * (rs * AS), u1 = acc[ai][1][m][1] * (rs * AS);
                const f32x2 a0 = swiglu2((f32x2){g0[0], g0[1]}, (f32x2){u0[0], u0[1]}, -1.4426950408889634f, 1.f), a1 = swiglu2((f32x2){g0[2], g0[3]}, (f32x2){u0[2], u0[3]}, -1.4426950408889634f, 1.f);
                const f32x2 a2 = swiglu2((f32x2){g1[0], g1[1]}, (f32x2){u1[0], u1[1]}, -1.4426950408889634f, 1.f), a3 = swiglu2((f32x2){g1[2], g1[3]}, (f32x2){u1[2], u1[3]}, -1.4426950408889634f, 1.f);
                u32x2 w; w.x = pk4_fp8(a0.x, a0.y, a1.x, a1.y); w.y = pk4_fp8(a2.x, a2.y, a3.x, a3.y);
                *(u32x2*)rowp = w; }
    }
};
struct EpiZ {
    static constexpr bool PERM = true; static constexpr int NVM = 16;
    bf16_t* out;
    __device__ __forceinline__ void operator()(const f32x4 (&acc)[2][2][4][2], const Unit& u, int wr, int wc, int fr, int fq) const {
        const int row0 = u.pm * BM + wr * 64 + fr, col0 = wc * 32 + 8 * fq;
#pragma unroll
        for (int ai = 0; ai < 2; ++ai)
#pragma unroll
            for (int m = 0; m < 4; ++m) { bf16_t* rowp = out + (size_t)(row0 + ai * HALF + m * 16) * 256 + col0;
#pragma unroll
                for (int bj = 0; bj < 2; ++bj) { const f32x4 v0 = acc[ai][bj][m][0], v1 = acc[ai][bj][m][1];
                    u32x4 w; w.x = pk2(v0[0], v0[1]); w.y = pk2(v0[2], v0[3]); w.z = pk2(v1[0], v1[1]); w.w = pk2(v1[2], v1[3]);
                    *(u32x4*)(rowp + bj * HALF) = w; } }
    }
};
struct EpiS5Y {
    static constexpr bool PERM = true; static constexpr int NVM = 8;
    unsigned char* O;
    __device__ __forceinline__ void operator()(const f32x4 (&acc)[2][2][4][2], const Unit& u, int wr, int wc, int fr, int fq) const {
        const int g = u.pm >> 2, brow0 = (u.pm & 3) * BM + wr * 64 + fr, ncol0 = (u.pn & 1) * BM + wc * 32 + 8 * fq;
        const bool odd = fq & 1;
#pragma unroll
        for (int ai = 0; ai < 2; ++ai)
#pragma unroll
            for (int bj = 0; bj < 2; ++bj) { const int t = (ncol0 + bj * HALF) >> 4;
#pragma unroll
                for (int mp = 0; mp < 2; ++mp) {
                    u32x2 w[2];
#pragma unroll
                    for (int k = 0; k < 2; ++k) { const int m = 2 * mp + k; f32x4 v0 = acc[ai][bj][m][0], v1 = acc[ai][bj][m][1];
#pragma unroll
                        for (int j = 0; j < 4; ++j) { v0[j] = gelu_tanh(v0[j]) * Y8_SCALE; v1[j] = gelu_tanh(v1[j]) * Y8_SCALE; }
                        w[k].x = pk4_fp8(v0[0], v0[1], v0[2], v0[3]); w[k].y = pk4_fp8(v1[0], v1[1], v1[2], v1[3]); }
                    const u32x2 snd = odd ? w[0] : w[1];
                    u32x2 rcv; rcv.x = (unsigned)__builtin_amdgcn_ds_swizzle((int)snd.x, 0x1F | (16 << 10)); rcv.y = (unsigned)__builtin_amdgcn_ds_swizzle((int)snd.y, 0x1F | (16 << 10));
                    const u32x4 v = odd ? (u32x4){rcv.x, rcv.y, w[1].x, w[1].y} : (u32x4){w[0].x, w[0].y, rcv.x, rcv.y};
                    const int brow = brow0 + ai * HALF + (2 * mp + (odd ? 1 : 0)) * 16, b = brow >> 6, ch = brow & 63;
                    *(u32x4*)(O + (size_t)(b * SEQ + ch * S5L + t) * DM + g * 16) = v; } }
    }
};
struct EpiGLU {
    static constexpr bool PERM = true; static constexpr int NVM = 16;
    bf16_t* io; float s;
    __device__ __forceinline__ void operator()(const f32x4 (&acc)[2][2][4][2], const Unit& u, int wr, int wc, int fr, int fq) const {
        const int row0 = u.pm * BM + wr * 64 + fr, col0 = u.pn * HALF + wc * 32 + 8 * fq;
        u32x4 r[8];
#pragma unroll
        for (int ai = 0; ai < 2; ++ai)
#pragma unroll
            for (int m = 0; m < 4; ++m) r[ai * 4 + m] = *(const u32x4*)(io + (size_t)(row0 + ai * HALF + m * 16) * DM + col0);
#pragma unroll
        for (int ai = 0; ai < 2; ++ai)
#pragma unroll
            for (int m = 0; m < 4; ++m) { const u32x4 w = r[ai * 4 + m]; const f32x4 v0 = acc[ai][0][m][0] * s, v1 = acc[ai][0][m][1] * s, g0 = acc[ai][1][m][0] * s, g1 = acc[ai][1][m][1] * s; u32x4 o;
                o.x = pk2(bflo(w.x) + v0[0] * fast_sigmoid(g0[0]), bfhi(w.x) + v0[1] * fast_sigmoid(g0[1])); o.y = pk2(bflo(w.y) + v0[2] * fast_sigmoid(g0[2]), bfhi(w.y) + v0[3] * fast_sigmoid(g0[3]));
                o.z = pk2(bflo(w.z) + v1[0] * fast_sigmoid(g1[0]), bfhi(w.z) + v1[1] * fast_sigmoid(g1[1])); o.w = pk2(bflo(w.w) + v1[2] * fast_sigmoid(g1[2]), bfhi(w.w) + v1[3] * fast_sigmoid(g1[3]));
                *(u32x4*)(io + (size_t)(row0 + ai * HALF + m * 16) * DM + col0) = o; }
    }
};
template <int NT> struct EpiSwiGLU8 {
    static constexpr bool PERM = true; static constexpr int NVM = 4;
    unsigned char* O; int ldo; float s;
    __device__ __forceinline__ void operator()(const f32x4 (&acc)[2][2][4][2], const Unit& u, int wr, int wc, int fr, int fq) const {
        const int row0 = u.pm * BM + wr * 64 + fr, col0 = (u.pn % NT) * HALF + wc * 32 + 8 * fq;
        const float ka = -1.4426950408889634f * s, c = 1.f / (s * s);
        unsigned char* rowp = O + (size_t)row0 * ldo + (col0 & ~15);
#pragma unroll
        for (int ai = 0; ai < 2; ++ai)
#pragma unroll
            for (int mp = 0; mp < 2; ++mp) {
                u32x2 w[2];
#pragma unroll
                for (int k = 0; k < 2; ++k) { const int m = 2 * mp + k;
                    const f32x4 g0 = acc[ai][0][m][0], g1 = acc[ai][0][m][1], u0 = acc[ai][1][m][0], u1 = acc[ai][1][m][1];
                    const f32x2 a0 = swiglu2((f32x2){g0[0], g0[1]}, (f32x2){u0[0], u0[1]}, ka, c), a1 = swiglu2((f32x2){g0[2], g0[3]}, (f32x2){u0[2], u0[3]}, ka, c);
                    const f32x2 a2 = swiglu2((f32x2){g1[0], g1[1]}, (f32x2){u1[0], u1[1]}, ka, c), a3 = swiglu2((f32x2){g1[2], g1[3]}, (f32x2){u1[2], u1[3]}, ka, c);
                    w[k].x = pk4_fp8(a0.x, a0.y, a1.x, a1.y); w[k].y = pk4_fp8(a2.x, a2.y, a3.x, a3.y); }
                const bool odd = fq & 1;
                const u32x2 snd = odd ? w[0] : w[1];
                u32x2 rcv; rcv.x = (unsigned)__builtin_amdgcn_ds_swizzle((int)snd.x, 0x1F | (16 << 10)); rcv.y = (unsigned)__builtin_amdgcn_ds_swizzle((int)snd.y, 0x1F | (16 << 10));
                const u32x4 v = odd ? (u32x4){rcv.x, rcv.y, w[1].x, w[1].y} : (u32x4){w[0].x, w[0].y, rcv.x, rcv.y};
                *(u32x4*)(rowp + (size_t)(ai * HALF + (2 * mp + (odd ? 1 : 0)) * 16) * ldo) = v; }
    }
};
template <int NT> struct EpiBf16Plain {
    static constexpr bool PERM = true; static constexpr int NVM = 16;
    bf16_t* O; int ldo; float s;
    __device__ __forceinline__ void operator()(const f32x4 (&acc)[2][2][4][2], const Unit& u, int wr, int wc, int fr, int fq) const {
        const int row0 = u.pm * BM + wr * 64 + fr, col0 = (u.pn % NT) * BM + wc * 32 + 8 * fq;
#pragma unroll
        for (int ai = 0; ai < 2; ++ai)
#pragma unroll
            for (int m = 0; m < 4; ++m) { bf16_t* rowp = O + (size_t)(row0 + ai * HALF + m * 16) * ldo + col0;
#pragma unroll
                for (int bj = 0; bj < 2; ++bj) { const f32x4 v0 = acc[ai][bj][m][0] * s, v1 = acc[ai][bj][m][1] * s;
                    u32x4 w; w.x = pk2(v0[0], v0[1]); w.y = pk2(v0[2], v0[3]); w.z = pk2(v1[0], v1[1]); w.w = pk2(v1[2], v1[3]);
                    *(u32x4*)(rowp + bj * HALF) = w; } }
    }
};

struct EpiPartF32 {
    static constexpr bool PERM = false; static constexpr int NVM = 32;
    float* out; int pm0; float s;
    __device__ __forceinline__ void operator()(const f32x4 (&acc)[2][2][4][2], const Unit& u, int wr, int wc, int fr, int fq) const {
        const int row0 = (u.pm - pm0) * BM + wr * 64 + fr, col0 = (u.pn & 7) * BM + wc * 32 + 4 * fq;
#pragma unroll
        for (int ai = 0; ai < 2; ++ai)
#pragma unroll
            for (int m = 0; m < 4; ++m) { float* rowp = out + (size_t)(row0 + ai * HALF + m * 16) * DM + col0;
#pragma unroll
                for (int bj = 0; bj < 2; ++bj)
#pragma unroll
                    for (int n = 0; n < 2; ++n) *(f32x4*)(rowp + bj * HALF + n * 16) = acc[ai][bj][m][n] * s; }
    }
};

template <int FMT = 0  , class Epi, class Sched>
__device__ __forceinline__ void gemm_phase(LAS unsigned char* lds, const Gemm g, const Sched& S, const Epi& E, const int wid) {
    const int lane = lane_id_v(), tid = wid * 64 + lane, wr = wid >> 2, wc = wid & 3, fr = lane & 15, fq = lane >> 4;
    const int K = g.K, nt = K / BK;
    unsigned voffA[2], voffB[2];
#pragma unroll
    for (int i = 0; i < 2; ++i) { int R, C; stage_rc(tid * 16 + i * 8192, R, C); const int Rb = Epi::PERM ? ((R & ~31) + perm32(R & 31)) : R;
        voffA[i] = (unsigned)(R * g.lda + C) * 2u; voffB[i] = (unsigned)(Rb * g.ldb + C) * 2u; }
    const size_t kstep = (size_t)(BK * 2);
    const size_t hsA = (size_t)HALF * g.lda * 2, hsB = (size_t)HALF * g.ldb * 2;
    const size_t tsA = 2 * hsA, tsB = 2 * hsB;
    const unsigned ldsw = (unsigned)wid * 1024u;
    const int aoff = lds_byte(wr * 64 + fr, fq * 8), boff = lds_byte(wc * 32 + fr, fq * 8);
    unsigned abase_u = (unsigned)(uintptr_t)lds + (unsigned)aoff, bbase_u = (unsigned)(uintptr_t)lds + (unsigned)(4 * HTB + boff);
    asm volatile("" : "+v"(abase_u), "+v"(bbase_u));
    const LAS unsigned char* abase = (const LAS unsigned char*)(uintptr_t)abase_u; const LAS unsigned char* bbase = (const LAS unsigned char*)(uintptr_t)bbase_u;
#define PG8_SA(b, h) (((b) * 2 + (h)) * HTB)
#define PG8_SB(b, h) ((4 + (b) * 2 + (h)) * HTB)
#define PG8_STAGE(bufoff, gbase, voff) do { _Pragma("unroll") for (int _i = 0; _i < 2; ++_i) { unsigned _vo = (voff)[_i]; asm volatile("" : "+v"(_vo));   \
        __builtin_amdgcn_global_load_lds((const unsigned*)((const char*)(gbase) + _vo), (LAS unsigned*)(lds + (bufoff) + ldsw + _i * 8192), 16, 0, 0); } } while (0)
#define PG8_RDA(off) (*(const LAS i32x4*)(abase + (off)))
#define PG8_RDB(off) (*(const LAS i32x4*)(bbase + (off)))
#define PG8_LDA(dst, b, h) do { _Pragma("unroll") for (int m = 0; m < 4; ++m) dst[m] = __builtin_shufflevector(PG8_RDA(PG8_SA(b, h) + m * 2048), PG8_RDA(PG8_SA(b, h) + m * 2048 + 1024), 0, 1, 2, 3, 4, 5, 6, 7); } while (0)
#define PG8_LDB(dst, b, h) do { _Pragma("unroll") for (int n = 0; n < 2; ++n) dst[n] = __builtin_shufflevector(PG8_RDB(PG8_SB(b, h) - 4 * HTB + n * 2048), PG8_RDB(PG8_SB(b, h) - 4 * HTB + n * 2048 + 1024), 0, 1, 2, 3, 4, 5, 6, 7); } while (0)
#define PG8_LO(x) __builtin_bit_cast(bf16x8, __builtin_shufflevector((x), (x), 0, 1, 2, 3))
#define PG8_HI(x) __builtin_bit_cast(bf16x8, __builtin_shufflevector((x), (x), 4, 5, 6, 7))
#define PG8_MMA(ai, bj, At, Bt) do { __builtin_amdgcn_s_setprio(1); _Pragma("unroll") for (int m = 0; m < 4; ++m) _Pragma("unroll") for (int n = 0; n < 2; ++n) { \
        if constexpr (FMT == 1) acc[ai][bj][m][n] = __builtin_amdgcn_mfma_scale_f32_16x16x128_f8f6f4(Bt[n], At[m], acc[ai][bj][m][n], 0, 0, 0, 0, 0, 0);   \
        else if constexpr (FMT == 2) acc[ai][bj][m][n] = __builtin_amdgcn_mfma_scale_f32_16x16x128_f8f6f4(Bt[n], At[m], acc[ai][bj][m][n], 2, 2, 0, Bt[n][6], 0, At[m][6]);   \
        else { acc[ai][bj][m][n] = __builtin_amdgcn_mfma_f32_16x16x32_bf16(PG8_LO(Bt[n]), PG8_LO(At[m]), acc[ai][bj][m][n], 0, 0, 0); \
               acc[ai][bj][m][n] = __builtin_amdgcn_mfma_f32_16x16x32_bf16(PG8_HI(Bt[n]), PG8_HI(At[m]), acc[ai][bj][m][n], 0, 0, 0); } } \
        __builtin_amdgcn_s_setprio(0); } while (0)
#define PG8_WAIT_V(n) asm volatile("s_waitcnt vmcnt(" #n ")" ::: "memory")
#define PG8_WAIT_L(n) asm volatile("s_waitcnt lgkmcnt(" #n ")" ::: "memory")
#define PG8_BAR __builtin_amdgcn_s_barrier()
#define PG8_SCHED __builtin_amdgcn_sched_barrier(0)
    Unit cur, nxt; int ui = 0;
    if (!S.next(0, cur)) return;
    f32x4 acc[2][2][4][2];
#pragma unroll
    for (int a = 0; a < 2; ++a)
#pragma unroll
        for (int b = 0; b < 2; ++b)
#pragma unroll
            for (int m = 0; m < 4; ++m)
#pragma unroll
                for (int n = 0; n < 2; ++n) acc[a][b][m][n] = (f32x4){0.f, 0.f, 0.f, 0.f};
    i32x8 At[4], B0[2], B1[2];
    const char* cA = (const char*)g.A + (size_t)cur.pm * tsA; const char* cB = (const char*)g.Bt + (size_t)cur.pn * tsB;
    S.a_ready(cur);
    PG8_STAGE(PG8_SB(0, 0), cB, voffB); PG8_STAGE(PG8_SB(0, 1), cB + hsB, voffB); PG8_STAGE(PG8_SA(0, 0), cA, voffA); PG8_STAGE(PG8_SA(0, 1), cA + hsA, voffA);
    if (wr == 1) PG8_BAR;
    PG8_WAIT_V(2); PG8_BAR;
    PG8_STAGE(PG8_SB(1, 0), cB + kstep, voffB); PG8_STAGE(PG8_SA(1, 0), cA + kstep, voffA); PG8_STAGE(PG8_SB(1, 1), cB + hsB + kstep, voffB);
    PG8_WAIT_V(6); PG8_BAR;
    for (;;) {
        const bool has_next = S.next(ui + 1, nxt);
        const char* nA = has_next ? (const char*)g.A + (size_t)nxt.pm * tsA : cA; const char* nB = has_next ? (const char*)g.Bt + (size_t)nxt.pn * tsB : cB;
#define PG8_TRIP(W1, W2) do { \
            const bool last = (t == nt - 2); \
            const char* a1 = cA + (size_t)(t + 1) * kstep; \
            const char* a2 = last ? nA : cA + (size_t)(t + 2) * kstep; const char* b2 = last ? nB : cB + (size_t)(t + 2) * kstep; \
            const char* a3 = a2 + kstep; const char* b3 = b2 + kstep; \
            if (last && has_next) S.a_ready(nxt); \
            PG8_LDB(B0, 0, 0); PG8_LDB(B1, 0, 1); PG8_SCHED; PG8_LDA(At, 0, 0); PG8_STAGE(PG8_SA(1, 1), a1 + hsA, voffA); \
            W1; PG8_WAIT_L(0); PG8_BAR; PG8_MMA(0, 0, At, B0); PG8_MMA(0, 1, At, B1); PG8_BAR; PG8_SCHED; \
            PG8_LDA(At, 0, 1); PG8_STAGE(PG8_SB(0, 0), b2, voffB); PG8_STAGE(PG8_SB(0, 1), b2 + hsB, voffB); PG8_STAGE(PG8_SA(0, 0), a2, voffA); \
            W2; PG8_WAIT_L(0); PG8_BAR; PG8_MMA(1, 0, At, B0); PG8_MMA(1, 1, At, B1); PG8_BAR; PG8_SCHED; \
            PG8_LDB(B0, 1, 0); PG8_LDB(B1, 1, 1); PG8_SCHED; PG8_LDA(At, 1, 0); PG8_STAGE(PG8_SA(0, 1), a2 + hsA, voffA); \
            PG8_WAIT_V(8); PG8_WAIT_L(0); PG8_BAR; PG8_MMA(0, 0, At, B0); PG8_MMA(0, 1, At, B1); PG8_BAR; PG8_SCHED; \
            PG8_LDA(At, 1, 1); PG8_STAGE(PG8_SB(1, 0), b3, voffB); PG8_STAGE(PG8_SB(1, 1), b3 + hsB, voffB); PG8_STAGE(PG8_SA(1, 0), a3, voffA); \
            PG8_WAIT_V(8); PG8_WAIT_L(0); PG8_BAR; PG8_MMA(1, 0, At, B0); PG8_MMA(1, 1, At, B1); PG8_BAR; PG8_SCHED; } while (0)
#define PG8_WAIT_VN(N) asm volatile("s_waitcnt vmcnt(%0)" :: "n"(N) : "memory")
        int t = 0;
        if (ui > 0) { PG8_TRIP(PG8_WAIT_VN(8 + Epi::NVM), PG8_WAIT_VN(8 + Epi::NVM)); t = 2; }
#pragma unroll 1
        for (; t < nt; t += 2) PG8_TRIP(PG8_WAIT_V(8), PG8_WAIT_V(8));
#undef PG8_TRIP
#undef PG8_WAIT_VN
        if (wr == 0) PG8_BAR;
        E(acc, cur, wr, wc, fr, fq); S.done(cur);
        if (!has_next) break;
#pragma unroll
        for (int a = 0; a < 2; ++a)
#pragma unroll
            for (int b = 0; b < 2; ++b)
#pragma unroll
                for (int m = 0; m < 4; ++m)
#pragma unroll
                    for (int n = 0; n < 2; ++n) acc[a][b][m][n] = (f32x4){0.f, 0.f, 0.f, 0.f};
        cur = nxt; cA = nA; cB = nB; ++ui;
        if (wr == 1) PG8_BAR;
    }
    PG8_WAIT_V(0);
    PG8_BAR;
#undef PG8_SA
#undef PG8_SB
#undef PG8_STAGE
#undef PG8_LDA
#undef PG8_LDB
#undef PG8_MMA
#undef PG8_LO
#undef PG8_HI
#undef PG8_RDA
#undef PG8_RDB
#undef PG8_WAIT_V
#undef PG8_WAIT_L
#undef PG8_BAR
#undef PG8_SCHED
}
}

#define XB_TMO      128
#define XB_XCNT(j)  (256  + 64 * (j))
#define XB_XSUB(j)  (1280 + 64 * (j))
#define XB_XGEN(j)  (2304 + 64 * (j))
#define XB_TOP      3328
#define XB_TOPGEN   3392
#define XCD_BAR_WORDS 3456
#define XB_SPIN_CAP (1u << 20)
__device__ __forceinline__ unsigned xb_ld(unsigned* p)              { return __hip_atomic_load(p, __ATOMIC_RELAXED, __HIP_MEMORY_SCOPE_AGENT); }
__device__ __forceinline__ unsigned xb_add(unsigned* p, unsigned v) { return __hip_atomic_fetch_add(p, v, __ATOMIC_RELAXED, __HIP_MEMORY_SCOPE_AGENT); }
__device__ __forceinline__ unsigned xb_xcc_id() { return (unsigned)__builtin_amdgcn_s_getreg((3 << 11) | 20) & 0xFu; }
#define XB_SPIN(cond, bar) do { unsigned _sp = 0; while (cond) { __builtin_amdgcn_s_sleep(1); \
    if ((++_sp & 255u) == 0u) { if (xb_ld(&(bar)[XB_TMO])) break; if (_sp > XB_SPIN_CAP) { atomicAdd(&(bar)[XB_TMO], 1u); break; } } } } while (0)
struct XcdBarrier { unsigned* bar; unsigned x; volatile LAS unsigned* st; };
__device__ __forceinline__ XcdBarrier xcd_barrier_post(unsigned* bar, volatile LAS unsigned* st, bool t0) {
    XcdBarrier b; b.bar = bar; b.x = xb_xcc_id(); b.st = st;
    if (t0) (void)xb_add(&bar[XB_XCNT(b.x)], 1u);
    return b;
}
__device__ __forceinline__ void xcd_barrier_complete(unsigned* bar, unsigned x, unsigned& nloc, unsigned& nx) {
    const unsigned G = gridDim.x * gridDim.y * gridDim.z;
    unsigned sum, cnt, mine, sp = 0u;
    for (;;) {
        sum = 0u; cnt = 0u; mine = 0u;
#pragma unroll
        for (unsigned j = 0; j < 16; ++j) { const unsigned c = xb_ld(&bar[XB_XCNT(j)]); sum += c; cnt += (c > 0u) ? 1u : 0u; mine = (j == x) ? c : mine; }
        if (sum == G) break;
        __builtin_amdgcn_s_sleep(1);
        if ((++sp & 255u) == 0u) { if (xb_ld(&bar[XB_TMO])) break; if (sp > XB_SPIN_CAP) { atomicAdd(&bar[XB_TMO], 1u); break; } }
    }
    nloc = mine > 0u ? mine : 1u; nx = cnt > 0u ? cnt : 1u;
}
__device__ __forceinline__ void xcd_barrier(const XcdBarrier& b, bool t0) {
    asm volatile("s_waitcnt vmcnt(0)" ::: "memory");
    __syncthreads();
    if (t0) {
        unsigned* bar = b.bar;
        __builtin_amdgcn_s_waitcnt(0);
        unsigned nloc = b.st[0], nx = b.st[1];
        if (nloc == 0u) { xcd_barrier_complete(bar, b.x, nloc, nx); b.st[0] = nloc; b.st[1] = nx; }
        const unsigned old = xb_add(&bar[XB_XSUB(b.x)], 1u);
        const unsigned gen = old / nloc;
        if (old + 1u == (gen + 1u) * nloc) {
            __builtin_amdgcn_fence(__ATOMIC_RELEASE, "agent");
            asm volatile("s_waitcnt vmcnt(0)" ::: "memory");
            const unsigned og = xb_add(&bar[XB_TOP], 1u);
            const unsigned tg = og / nx;
            if (og + 1u == (tg + 1u) * nx) xb_add(&bar[XB_TOPGEN], 1u);
            else XB_SPIN(xb_ld(&bar[XB_TOPGEN]) == tg, bar);
            __builtin_amdgcn_fence(__ATOMIC_ACQUIRE, "agent");
            xb_add(&bar[XB_XGEN(b.x)], 1u);
            asm volatile("s_waitcnt vmcnt(0)" ::: "memory");
        } else {
            XB_SPIN(xb_ld(&bar[XB_XGEN(b.x)]) == gen, bar);
            __builtin_amdgcn_fence(__ATOMIC_ACQUIRE, "agent");
            asm volatile("s_waitcnt vmcnt(0)" ::: "memory");
        }
    }
    __syncthreads();
}

struct Args {
    const float* in[30];
    float* out; unsigned char* ws;
    int ph_lo, ph_hi;
};
typedef const __attribute__((address_space(4))) Args* KA;
enum { I_X = 0, I_MIXNORM_E, I_WIN, I_GMNORM, I_GMWS, I_GMBS, I_LQ1, I_LK1, I_LQ2, I_LK2, I_SUBLN, I_WOUT, I_FFNNORM, I_FFNGU, I_FFNDN,
       I_MIXNORM_O, I_LAMRE, I_LAMIM, I_LOGDT, I_BRE, I_BIM, I_CRE, I_CIM, I_S5D, I_GLUW, I_MOENORM, I_ROUTER, I_EGU, I_EDN, I_FINALNORM };

__device__ __forceinline__ float row_load_rstd(const float* xrow, int lane, f32x4 (&v)[8]) {
    const f32x4* xr = (const f32x4*)xrow + lane; float s = 0.f;
#pragma unroll
    for (int j = 0; j < 8; ++j) { v[j] = xr[64 * j]; s += (v[j].x * v[j].x + v[j].y * v[j].y) + (v[j].z * v[j].z + v[j].w * v[j].w); }
    return rsqrtf(wave_sum(s) * (1.f / DM) + EPS);
}
__device__ __forceinline__ void rmsnorm_rows_bf16(const float* X, const float* gain, bf16_t* O, int gw, int NGW, int lane) {
    f32x4 gv[8];
#pragma unroll
    for (int j = 0; j < 8; ++j) gv[j] = ((const f32x4*)gain)[lane + 64 * j];
    for (int m = gw; m < M; m += NGW) {
        f32x4 v[8]; const float rstd = row_load_rstd(X + (size_t)m * DM, lane, v);
        u32x2* o = (u32x2*)(O + (size_t)m * DM) + lane;
#pragma unroll
        for (int j = 0; j < 8; ++j) { u32x2 w; w.x = pk2(v[j].x * rstd * gv[j].x, v[j].y * rstd * gv[j].y); w.y = pk2(v[j].z * rstd * gv[j].z, v[j].w * rstd * gv[j].w); o[64 * j] = w; }
    }
}

__device__ __forceinline__ void p0_transpose_item(const float* W, int K, int N, bf16_t* WT, int F  , LAS float* scr, int item, int lane, const float* gain = nullptr  ) {
    const int nblk = N / 32, kb = item / nblk, nb = item % nblk, k0 = 64 * kb, n0 = 32 * nb;
    int d0 = n0;
    if (F) { const int j = (n0 < F) ? n0 : n0 - F; d0 = (j >> 7) * 256 + (j & 127) + ((n0 < F) ? 0 : 128); }
    const int c = lane & 7;
    f32x4 ga = (f32x4){1.f, 1.f, 1.f, 1.f}, gb = ga;
    if (gain) { ga = *(const f32x4*)(gain + k0 + 8 * c); gb = *(const f32x4*)(gain + k0 + 8 * c + 4); }
    { float tv[32]; const float* wp = W + (size_t)(k0 + (lane >> 5)) * N + n0 + (lane & 31);
#pragma unroll
      for (int i = 0; i < 32; ++i) tv[i] = __builtin_nontemporal_load(wp + (size_t)(2 * i) * N);
#pragma unroll
      for (int i = 0; i < 32; ++i) scr[(2 * i + (lane >> 5)) * 33 + (lane & 31)] = tv[i]; }
    asm volatile("s_waitcnt lgkmcnt(0)" ::: "memory");
#pragma unroll
    for (int j = 0; j < 4; ++j) { const int n = (lane >> 3) + 8 * j; const LAS float* s = scr + (8 * c) * 33 + n;
        u32x4 o; o.x = pk2(s[0 * 33] * ga[0], s[1 * 33] * ga[1]); o.y = pk2(s[2 * 33] * ga[2], s[3 * 33] * ga[3]); o.z = pk2(s[4 * 33] * gb[0], s[5 * 33] * gb[1]); o.w = pk2(s[6 * 33] * gb[2], s[7 * 33] * gb[3]);
        *(u32x4*)(WT + (size_t)(d0 + n) * K + k0 + 8 * c) = o; }
    asm volatile("s_waitcnt lgkmcnt(0)" ::: "memory");
}

__device__ __forceinline__ void p0_transpose_item8(const float* W, int K, int N, unsigned char* WT, int F, float scale, LAS float* scr, int item, int lane) {
    const int nblk = N / 32, kb = item / nblk, nb = item % nblk, k0 = 128 * kb, n0 = 32 * nb;
    int d0 = n0;
    if (F) { const int j = (n0 < F) ? n0 : n0 - F; d0 = (j >> 7) * 256 + (j & 127) + ((n0 < F) ? 0 : 128); }
    { float tv[64]; const float* wp = W + (size_t)(k0 + (lane >> 5)) * N + n0 + (lane & 31);
#pragma unroll
      for (int i = 0; i < 64; ++i) tv[i] = __builtin_nontemporal_load(wp + (size_t)(2 * i) * N);
#pragma unroll
      for (int i = 0; i < 64; ++i) scr[(2 * i + (lane >> 5)) * 33 + (lane & 31)] = tv[i]; }
    asm volatile("s_waitcnt lgkmcnt(0)" ::: "memory");
    const int c = lane & 7;
#pragma unroll
    for (int j = 0; j < 4; ++j) { const int n = (lane >> 3) + 8 * j; const LAS float* sp = scr + (16 * c) * 33 + n;
        u32x4 o;
        o.x = pk4_fp8(sp[0 * 33] * scale, sp[1 * 33] * scale, sp[2 * 33] * scale, sp[3 * 33] * scale); o.y = pk4_fp8(sp[4 * 33] * scale, sp[5 * 33] * scale, sp[6 * 33] * scale, sp[7 * 33] * scale);
        o.z = pk4_fp8(sp[8 * 33] * scale, sp[9 * 33] * scale, sp[10 * 33] * scale, sp[11 * 33] * scale); o.w = pk4_fp8(sp[12 * 33] * scale, sp[13 * 33] * scale, sp[14 * 33] * scale, sp[15 * 33] * scale);
        *(u32x4*)(WT + (size_t)(d0 + n) * K + k0 + 16 * c) = o; }
    asm volatile("s_waitcnt lgkmcnt(0)" ::: "memory");
}

__device__ __forceinline__ void p0_transpose_item6(const float* W, int K, int N, unsigned char* WT, int F, LAS float* scr, int item, int lane) {
    const int nblk = N / 32, kb = item / nblk, nb = item % nblk, k0 = 128 * kb, n0 = 32 * nb;
    int d0 = n0;
    if (F) { const int j = (n0 < F) ? n0 : n0 - F; d0 = (j >> 7) * 256 + (j & 127) + ((n0 < F) ? 0 : 128); }
    { float tv[64]; const float* wp = W + (size_t)(k0 + (lane >> 5)) * N + n0 + (lane & 31);
#pragma unroll
      for (int i = 0; i < 64; ++i) tv[i] = __builtin_nontemporal_load(wp + (size_t)(2 * i) * N);
#pragma unroll
      for (int i = 0; i < 64; ++i) scr[(2 * i + (lane >> 5)) * 33 + (lane & 31)] = tv[i]; }
    asm volatile("s_waitcnt lgkmcnt(0)" ::: "memory");
    const int c = lane & 3;
#pragma unroll
    for (int j = 0; j < 2; ++j) { const int n = (lane >> 2) + 16 * j; const LAS float* sp = scr + (32 * c) * 33 + n;
        float x[32];
#pragma unroll
        for (int q = 0; q < 32; ++q) x[q] = sp[q * 33];
        u32x6 pk; unsigned sb; quant_fp6_block(x, pk, sb);
        unsigned char* dst = WT + (size_t)(d0 + n) * K + k0 + 16 * c;
        *(u32x4*)dst = (u32x4){pk[0], pk[1], pk[2], pk[3]}; *(u32x4*)(dst + 64) = (u32x4){pk[4], pk[5], sb, 0u}; }
    asm volatile("s_waitcnt lgkmcnt(0)" ::: "memory");
}

__device__ __forceinline__ void s5_prep_unit(KA a, LAS unsigned char* lds, int g, int nh, int tid) {
    constexpr int PS = 65, KS = 260;
    LAS float* PW = (LAS float*)lds;
    LAS float* BB = PW + 2 * 33 * PS * 2;
    LAS float* CM = BB + 2 * 64 * 16 * 2;
    LAS float* KD = CM + 2 * 16 * PS * 2;
    const float* lam_re = a->in[I_LAMRE]; const float* lam_im = a->in[I_LAMIM]; const float* log_dt = a->in[I_LOGDT];
    const float* b_re = a->in[I_BRE]; const float* b_im = a->in[I_BIM]; const float* c_re = a->in[I_CRE]; const float* c_im = a->in[I_CIM]; const float* dsk = a->in[I_S5D];
    if (tid < 128) {
        const int d = tid >> 6, p = tid & 63;
        const float dt = expf(log_dt[d * S5G + g]);
        const float lr = lam_re[(d * S5G + g) * 64 + p], li = lam_im[(d * S5G + g) * 64 + p];
        const float ar = lr * dt, ai = li * dt;
        for (int j = 0; j <= 32; ++j) {
            const float mag = expf((float)j * ar);
            const double rev = (double)j * (double)ai * 0.15915494309189535; const float fr = (float)(rev - rint(rev));
            PW[((d * 33 + j) * PS + p) * 2 + 0] = mag * __builtin_amdgcn_cosf(fr); PW[((d * 33 + j) * PS + p) * 2 + 1] = mag * __builtin_amdgcn_sinf(fr);
        }
        asm volatile("s_waitcnt lgkmcnt(0)" ::: "memory");
        const float xr = PW[((d * 33 + 1) * PS + p) * 2 + 0] - 1.f, xi = PW[((d * 33 + 1) * PS + p) * 2 + 1];
        const float den = 1.f / (lr * lr + li * li), cr = (xr * lr + xi * li) * den, ci = (xi * lr - xr * li) * den;
        for (int c = 0; c < 16; ++c) { const float br = b_re[((size_t)(d * S5G + g) * 64 + p) * 16 + c], bi = b_im[((size_t)(d * S5G + g) * 64 + p) * 16 + c];
            BB[((d * 64 + p) * 16 + c) * 2 + 0] = cr * br - ci * bi; BB[((d * 64 + p) * 16 + c) * 2 + 1] = cr * bi + ci * br; }
        for (int c = 0; c < 16; ++c) { CM[((d * 16 + c) * PS + p) * 2 + 0] = c_re[((size_t)(d * S5G + g) * 16 + c) * 64 + p]; CM[((d * 16 + c) * PS + p) * 2 + 1] = c_im[((size_t)(d * S5G + g) * 16 + c) * 64 + p]; }
    }
    __syncthreads();
    for (int q = tid; q < 1024; q += 512) {
        const int d = q >> 9, j = (q >> 4) & 31, co = q & 15; float acc[16];
#pragma unroll
        for (int c = 0; c < 16; ++c) acc[c] = 0.f;
        for (int p = 0; p < 64; ++p) {
            const float cr = CM[((d * 16 + co) * PS + p) * 2], ci = CM[((d * 16 + co) * PS + p) * 2 + 1], pr = PW[((d * 33 + j) * PS + p) * 2], pi = PW[((d * 33 + j) * PS + p) * 2 + 1];
            const float wr = cr * pr - ci * pi, wi = cr * pi + ci * pr;
            const LAS float* bb = BB + (d * 64 + p) * 32;
#pragma unroll
            for (int c = 0; c < 16; ++c) acc[c] += wr * bb[2 * c] - wi * bb[2 * c + 1];
        }
#pragma unroll
        for (int c = 0; c < 16; ++c) KD[(d * 32 + j) * KS + co * 16 + c] = acc[c];
    }
    __syncthreads();
    bf16_t* BY = (bf16_t*)(a->ws + WS_S5BY) + (size_t)g * 512 * S5K; bf16_t* BZ = (bf16_t*)(a->ws + WS_S5BZ) + (size_t)g * 256 * 512;
    for (int id = tid; id < 256 * 64; id += 512) {
        const int nl = id >> 6, kc = id & 63, n = 256 * nh + nl, t = n >> 4, co = n & 15, s = kc >> 1, c0 = (kc & 1) * 8; float v[8];
#pragma unroll
        for (int c = 0; c < 8; ++c) { float x = 0.f;
            if (t >= s) x += KD[(0 * 32 + (t - s)) * KS + co * 16 + c0 + c];
            if (s >= t) x += KD[(1 * 32 + (s - t)) * KS + co * 16 + c0 + c];
            if (t == s && c0 + c == co) x += dsk[g * 16 + co];
            v[c] = x; }
        u32x4 w; w.x = pk2(v[0], v[1]); w.y = pk2(v[2], v[3]); w.z = pk2(v[4], v[5]); w.w = pk2(v[6], v[7]);
        *(u32x4*)(BY + (size_t)n * S5K + kc * 8) = w;
    }
    for (int id = tid; id < 256 * 32; id += 512) {
        const int nl = id >> 5, kc = id & 31, n = 256 * nh + nl, t = n >> 4, co = n & 15, d = kc >> 4, p0 = (kc & 15) * 4, e = d ? (32 - t) : (t + 1); float v[8];
#pragma unroll
        for (int q = 0; q < 4; ++q) { const int p = p0 + q; const float cr = CM[((d * 16 + co) * PS + p) * 2], ci = CM[((d * 16 + co) * PS + p) * 2 + 1], pr = PW[((d * 33 + e) * PS + p) * 2], pi = PW[((d * 33 + e) * PS + p) * 2 + 1];
            v[2 * q] = cr * pr - ci * pi; v[2 * q + 1] = -(cr * pi + ci * pr); }
        u32x4 w; w.x = pk2(v[0], v[1]); w.y = pk2(v[2], v[3]); w.z = pk2(v[4], v[5]); w.w = pk2(v[6], v[7]);
        *(u32x4*)(BY + (size_t)n * S5K + 512 + kc * 8) = w;
    }
    for (int id = tid; id < 128 * 64; id += 512) {
        const int nl = id >> 6, kc = id & 63, d = nh, p = nl >> 1, ri = nl & 1, s = kc >> 1, c0 = (kc & 1) * 8, e = d ? s : (31 - s); float v[8];
        const float pr = PW[((d * 33 + e) * PS + p) * 2], pi = PW[((d * 33 + e) * PS + p) * 2 + 1];
#pragma unroll
        for (int c = 0; c < 8; ++c) { const float br = BB[((d * 64 + p) * 16 + c0 + c) * 2], bi = BB[((d * 64 + p) * 16 + c0 + c) * 2 + 1]; v[c] = ri ? (pr * bi + pi * br) : (pr * br - pi * bi); }
        u32x4 w; w.x = pk2(v[0], v[1]); w.y = pk2(v[2], v[3]); w.z = pk2(v[4], v[5]); w.w = pk2(v[6], v[7]);
        *(u32x4*)(BZ + (size_t)(128 * nh + nl) * 512 + kc * 8) = w;
    }
    __syncthreads();
}

__device__ __forceinline__ void gating_phase(KA a, LAS unsigned char* lds, int u0, int ustride, int tid) {
    int lane = tid & 63; asm volatile("" : "+v"(lane)); const int wid = tid >> 6;
    const bf16_t* PROJ = (const bf16_t*)(a->ws + WS_PROJ); bf16_t* MIXED = (bf16_t*)(a->ws + WS_MIXED);
    LAS bf16_t* VT = (LAS bf16_t*)lds;
    LAS bf16_t* OT = (LAS bf16_t*)(lds + 69632);
    const int fr = lane & 15, fq = lane >> 4;
    u32x2 rawv[16];
#define GT_TOK0(u_) ((size_t)((u_) >> 6) * SEQ + (((u_) >> 2) & 15) * 128)
#define GT_LDV(u_) do { const size_t t0_ = GT_TOK0(u_); const int g_ = (u_) & 3; _Pragma("unroll") for (int i = 0; i < 16; ++i) rawv[i] = *(const u32x2*)(PROJ + (t0_ + wid * 16 + i) * MIX_IN + 1024 + g_ * 256 + 4 * lane); } while (0)
    if (u0 < 1024) GT_LDV(u0);
    for (int u = u0; u < 1024; u += ustride) {
        const int g = u & 3; const size_t tok0 = GT_TOK0(u);
        const bf16_t* WSB = (const bf16_t*)(a->ws + WS_GMWS) + g * 128 * 128; const float* gmn = a->in[I_GMNORM] + g * 256; const float* gbs = a->in[I_GMBS] + g * 128;
        { const f32x4 gn = *(const f32x4*)(gmn + 4 * lane);
#pragma unroll
          for (int i = 0; i < 16; ++i) { const int s = wid * 16 + i;
            const u32x2 raw = rawv[i];
            const float v0 = bflo(raw.x), v1 = bfhi(raw.x), v2 = bflo(raw.y), v3 = bfhi(raw.y);
            const float rstd = rsqrtf(wave_sum((v0 * v0 + v1 * v1) + (v2 * v2 + v3 * v3)) * (1.f / 256.f) + EPS);
            const unsigned w0 = pk2(v0 * rstd * gn.x, v1 * rstd * gn.y), w1 = pk2(v2 * rstd * gn.z, v3 * rstd * gn.w);
            VT[(4 * lane + 0) * 136 + s] = (bf16_t)(w0 & 0xffff); VT[(4 * lane + 1) * 136 + s] = (bf16_t)(w0 >> 16);
            VT[(4 * lane + 2) * 136 + s] = (bf16_t)(w1 & 0xffff); VT[(4 * lane + 3) * 136 + s] = (bf16_t)(w1 >> 16); } }
        __syncthreads();
        if (u + ustride < 1024) GT_LDV(u + ustride);
        u32x4 uv[8];
#pragma unroll
        for (int j = 0; j < 8; ++j) { const int idx = tid + 512 * j, t = idx >> 5, ch = idx & 31; uv[j] = *(const u32x4*)(PROJ + (tok0 + t) * MIX_IN + g * 256 + ch * 8); }
        f32x4 acc[2][8];
#pragma unroll
        for (int cb = 0; cb < 2; ++cb)
#pragma unroll
            for (int tb = 0; tb < 8; ++tb) acc[cb][tb] = (f32x4){0.f, 0.f, 0.f, 0.f};
#pragma unroll 2
        for (int ks = 0; ks < 4; ++ks) {
            bf16x8 af[2];
#pragma unroll
            for (int cb = 0; cb < 2; ++cb) af[cb] = *(const LAS bf16x8*)(VT + (32 * wid + 16 * cb + fr) * 136 + 32 * ks + 8 * fq);
#pragma unroll
            for (int tb = 0; tb < 8; ++tb) { const bf16x8 bfm = *(const bf16x8*)(WSB + (16 * tb + fr) * 128 + 32 * ks + 8 * fq);
#pragma unroll
                for (int cb = 0; cb < 2; ++cb) acc[cb][tb] = __builtin_amdgcn_mfma_f32_16x16x32_bf16(af[cb], bfm, acc[cb][tb], 0, 0, 0); }
        }
#pragma unroll
        for (int tb = 0; tb < 8; ++tb) { const int t = 16 * tb + fr; const float bs = gbs[t];
#pragma unroll
            for (int cb = 0; cb < 2; ++cb) { const int c = 32 * wid + 16 * cb + 4 * fq; const f32x4 mx = acc[cb][tb];
                u32x2 w; w.x = pk2(mx[0] + bs, mx[1] + bs); w.y = pk2(mx[2] + bs, mx[3] + bs);
                *(LAS u32x2*)(OT + t * 264 + c) = w; } }
        __syncthreads();
#pragma unroll
        for (int j = 0; j < 8; ++j) { const int idx = tid + 512 * j, t = idx >> 5, ch = idx & 31; const u32x4 mv = *(const LAS u32x4*)(OT + t * 264 + ch * 8); const u32x4 u4 = uv[j]; u32x4 w;
            w.x = pk2(bflo(u4.x) * bflo(mv.x), bfhi(u4.x) * bfhi(mv.x)); w.y = pk2(bflo(u4.y) * bflo(mv.y), bfhi(u4.y) * bfhi(mv.y));
            w.z = pk2(bflo(u4.z) * bflo(mv.z), bfhi(u4.z) * bfhi(mv.z)); w.w = pk2(bflo(u4.w) * bflo(mv.w), bfhi(u4.w) * bfhi(mv.w));
            *(u32x4*)(MIXED + (tok0 + t) * DM + g * 256 + ch * 8) = w; }
        __syncthreads();
    }
#undef GT_LDV
#undef GT_TOK0
}

constexpr int AT_KB = 9216, AT_VB = 20480, AT_K0 = 0, AT_V0 = 2 * AT_KB, AT_SCR = AT_V0 + 2 * AT_VB  , AT_SSQ = AT_SCR + 8 * 256  , AT_Q = AT_SSQ + 8 * 4224  ;
__device__ __forceinline__ int crow(int r, int hi) { return (r & 3) + 8 * (r >> 2) + 4 * hi; }
__device__ __forceinline__ void attn_unit(KA a, LAS unsigned char* lds, int b, int h, int qb, float lam, int tid_in) {
    int tid = tid_in; asm volatile("" : "+v"(tid));
    int lane = tid & 63; asm volatile("" : "+v"(lane));
    const int wid = __builtin_amdgcn_readfirstlane(tid >> 6), r32 = lane & 31, hi = lane >> 5;
    const bf16_t* PROJ = (const bf16_t*)(a->ws + WS_PROJ); bf16_t* MIXED = (bf16_t*)(a->ws + WS_MIXED); float* O0S = (float*)(a->ws + WS_O0);
    const size_t tokb = (size_t)b * SEQ; const int q0 = qb * 256 + wid * 32;
    const float sl2 = exp2f(-(float)(h + 1)) * 1.4426950408889634f;
    LAS float* scr = (LAS float*)(lds + AT_SCR) + wid * 64;
    LAS float* ssq = (LAS float*)(lds + AT_SSQ) + wid * 1056;
    const int krow = tid >> 3, kch = tid & 7;
    const int vrow0 = tid >> 4, vch = tid & 15;
    const int tr_q = (lane & 15) >> 2, tr_p = lane & 3, tr_blk = (lane >> 4) & 1;
    const int vrd = (4 * hi + tr_q) * 320 + (16 * tr_blk + 4 * tr_p) * 2;
    const int t0 = 4 * qb;
    for (int mp = 0; mp < 2; ++mp) {
        const bf16_t* Kg = PROJ + tokb * MIX_IN + 3072 + h * 128 + mp * 64;
        const bf16_t* Vg = PROJ + tokb * MIX_IN + 4096 + h * 128;
        LAS unsigned char* QB = lds + AT_Q + wid * 4608 + r32 * 144 + hi * 16;
#pragma unroll
        for (int d0 = 0; d0 < 4; ++d0) *(LAS bf16x8*)(QB + d0 * 32) = *(const bf16x8*)(PROJ + (tokb + q0 + r32) * MIX_IN + 2048 + h * 128 + mp * 64 + d0 * 16 + hi * 8);
        f32x16 o[4];
#pragma unroll
        for (int e = 0; e < 4; ++e)
#pragma unroll
            for (int r = 0; r < 16; ++r) o[e][r] = 0.f;
        float mref = -1e30f, lsum = 0.f;
        u32x4 kreg, vreg0, vreg1;
#define AT_LDK(i_) (*(const u32x4*)(Kg + (size_t)((((t0 + (i_)) & 31) * 64) + krow) * MIX_IN + kch * 8))
#define AT_LDV(i_, ro) (*(const u32x4*)(Vg + (size_t)((((t0 + (i_)) & 31) * 64) + vrow0 + (ro)) * MIX_IN + vch * 8))
#define AT_STK(buf, v) (*(LAS u32x4*)(lds + AT_K0 + (buf) * AT_KB + krow * 144 + kch * 16) = (v))
#define AT_STV(buf, ro, v) (*(LAS u32x4*)(lds + AT_V0 + (buf) * AT_VB + (vrow0 + (ro)) * 320 + vch * 16) = (v))
#define AT_QK(D0, D1, buf) do { const LAS unsigned char* KB_ = lds + AT_K0 + (buf) * AT_KB; \
            _Pragma("unroll") for (int r_ = 0; r_ < 16; ++r_) { D0[r_] = 0.f; D1[r_] = 0.f; } \
            _Pragma("unroll") for (int d0 = 0; d0 < 4; ++d0) { \
                const bf16x8 ka = *(const LAS bf16x8*)(KB_ + r32 * 144 + d0 * 32 + hi * 16), kb = *(const LAS bf16x8*)(KB_ + (32 + r32) * 144 + d0 * 32 + hi * 16); \
                const bf16x8 qf = *(const LAS bf16x8*)(QB + d0 * 32); \
                D0 = __builtin_amdgcn_mfma_f32_32x32x16_bf16(ka, qf, D0, 0, 0, 0); D1 = __builtin_amdgcn_mfma_f32_32x32x16_bf16(kb, qf, D1, 0, 0, 0); } } while (0)
        { kreg = AT_LDK(0); vreg0 = AT_LDV(0, 0); vreg1 = AT_LDV(0, 32); const u32x4 k1 = AT_LDK(1);
          AT_STK(0, kreg); AT_STV(0, 0, vreg0); AT_STV(0, 32, vreg1); AT_STK(1, k1); }
        __syncthreads();
        f32x16 p0, p1;
        AT_QK(p0, p1, 0);
        __syncthreads();
#define AT_STEP(HAS1, HAS2) do { \
            const int k0 = ((t0 + it) & 31) * 64; \
            if (HAS2) kreg = AT_LDK(it + 2); \
            if (HAS1) { vreg0 = AT_LDV(it + 1, 0); vreg1 = AT_LDV(it + 1, 32); } \
            f32x16 n0, n1; \
            if (HAS1) AT_QK(n0, n1, (it + 1) & 1); \
            __builtin_amdgcn_sched_barrier(0); \
            const LAS unsigned char* VB = lds + AT_V0 + (it & 1) * AT_VB; \
            float xf = (float)(q0 + r32 - k0 - 4 * hi); asm volatile("" : "+v"(xf));   \
            float rm = -1e30f; \
            _Pragma("unroll") for (int r = 0; r < 16; ++r) { const float dd = xf - (float)((r & 3) + 8 * (r >> 2)); \
                p0[r] = p0[r] - sl2 * fabsf(dd); p1[r] = p1[r] - sl2 * fabsf(dd - 32.f); rm = fmaxf(rm, fmaxf(p0[r], p1[r])); } \
            rm = half_max(rm); \
            if (__any(rm > mref + 8.f)) { \
                const float mn = fmaxf(mref, rm), al = __builtin_amdgcn_exp2f(mref - mn); mref = mn; lsum *= al; \
                if (hi == 0) scr[r32] = al; \
                asm volatile("s_waitcnt lgkmcnt(0)" ::: "memory"); \
                _Pragma("unroll") for (int r = 0; r < 16; ++r) { const float f = scr[crow(r, hi)]; \
                    _Pragma("unroll") for (int e = 0; e < 4; ++e) o[e][r] *= f; } \
            } \
            float ps = 0.f; \
            _Pragma("unroll") for (int r = 0; r < 16; ++r) { p0[r] = __builtin_amdgcn_exp2f(p0[r] - mref); p1[r] = __builtin_amdgcn_exp2f(p1[r] - mref); ps += p0[r]; ps += p1[r]; }   \
            lsum += ps; \
            bf16x8 pa[4]; \
            { u32x4 w; \
              w.x = pk2(p0[0], p0[1]); w.y = pk2(p0[2], p0[3]); w.z = pk2(p0[4], p0[5]); w.w = pk2(p0[6], p0[7]); pa[0] = __builtin_bit_cast(bf16x8, w); \
              w.x = pk2(p0[8], p0[9]); w.y = pk2(p0[10], p0[11]); w.z = pk2(p0[12], p0[13]); w.w = pk2(p0[14], p0[15]); pa[1] = __builtin_bit_cast(bf16x8, w); \
              w.x = pk2(p1[0], p1[1]); w.y = pk2(p1[2], p1[3]); w.z = pk2(p1[4], p1[5]); w.w = pk2(p1[6], p1[7]); pa[2] = __builtin_bit_cast(bf16x8, w); \
              w.x = pk2(p1[8], p1[9]); w.y = pk2(p1[10], p1[11]); w.z = pk2(p1[12], p1[13]); w.w = pk2(p1[14], p1[15]); pa[3] = __builtin_bit_cast(bf16x8, w); } \
            __builtin_amdgcn_sched_barrier(0); \
            _Pragma("unroll") for (int ks = 0; ks < 4; ++ks) { \
                _Pragma("unroll") for (int e = 0; e < 4; ++e) { \
                    const LAS unsigned char* vp = VB + vrd + ks * 16 * 320 + e * 64; \
                    const s16x4 lo = __builtin_amdgcn_ds_read_tr16_b64_v4i16((LAS s16x4*)(vp)), hh = __builtin_amdgcn_ds_read_tr16_b64_v4i16((LAS s16x4*)(vp + 8 * 320)); \
                    const bf16x8 vf = (bf16x8){lo[0], lo[1], lo[2], lo[3], hh[0], hh[1], hh[2], hh[3]}; \
                    o[e] = __builtin_amdgcn_mfma_f32_32x32x16_bf16(pa[ks], vf, o[e], 0, 0, 0); } \
                __builtin_amdgcn_sched_barrier(0); } \
            if (HAS2) AT_STK(it & 1, kreg); \
            if (HAS1) { AT_STV((it + 1) & 1, 0, vreg0); AT_STV((it + 1) & 1, 32, vreg1); } \
            __syncthreads(); \
            if (HAS1) { p0 = n0; p1 = n1; } } while (0)
        int it = 0;
        for (; it < 30; ++it) AT_STEP(true, true);
        AT_STEP(true, false); ++it;
        AT_STEP(false, false);
#undef AT_STEP
#undef AT_QK
#undef AT_LDK
#undef AT_LDV
#undef AT_STK
#undef AT_STV
        int r32e = r32, hie = hi; asm volatile("" : "+v"(r32e), "+v"(hie));
        lsum = half_sum(lsum);
        if (hie == 0) scr[r32e] = 1.f / lsum;
        asm volatile("s_waitcnt lgkmcnt(0)" ::: "memory");
#pragma unroll
        for (int r = 0; r < 16; ++r) { const float l_ = scr[crow(r, hie)];
#pragma unroll
            for (int e = 0; e < 4; ++e) o[e][r] *= l_; }
        int tide = tid; asm volatile("" : "+v"(tide));
        u32x4* ob = (u32x4*)O0S + (size_t)((b * 8 + h) * 8 + qb) * (8 * 512) + tide;
        if (mp == 0) {
#pragma unroll
            for (int e = 0; e < 4; ++e) {
#pragma unroll
                for (int h2 = 0; h2 < 2; ++h2) { u32x4 w; w.x = pk2(o[e][8 * h2 + 0], o[e][8 * h2 + 1]); w.y = pk2(o[e][8 * h2 + 2], o[e][8 * h2 + 3]); w.z = pk2(o[e][8 * h2 + 4], o[e][8 * h2 + 5]); w.w = pk2(o[e][8 * h2 + 6], o[e][8 * h2 + 7]);
                    ob[(2 * e + h2) * 512] = w; }
                __builtin_amdgcn_sched_barrier(0); }
        } else {
            float ss[16];
#pragma unroll
            for (int h2 = 0; h2 < 2; ++h2) {
                u32x4 ov[4];
#pragma unroll
                for (int e = 0; e < 4; ++e) ov[e] = ob[(2 * e + h2) * 512];
                __builtin_amdgcn_sched_barrier(0);
#pragma unroll
                for (int rr = 0; rr < 8; ++rr) { float s2 = 0.f;
#pragma unroll
                    for (int e = 0; e < 4; ++e) { const unsigned dw = ov[e][rr >> 1]; const float o0 = (rr & 1) ? bfhi(dw) : bflo(dw);
                        const float d = o0 - lam * o[e][8 * h2 + rr]; o[e][8 * h2 + rr] = d; s2 += d * d; }
                    ss[8 * h2 + rr] = s2; }
                __builtin_amdgcn_sched_barrier(0);
            }
#pragma unroll
            for (int r = 0; r < 16; ++r) ssq[crow(r, hie) * 33 + r32e] = ss[r];
            asm volatile("s_waitcnt lgkmcnt(0)" ::: "memory");
            { float tot = 0.f;
#pragma unroll
              for (int j = 0; j < 32; ++j) tot += ssq[r32e * 33 + j];
              if (hie == 0) scr[r32e] = rsqrtf(tot * (1.f / 128.f) + EPS) * 0.8f; }
            asm volatile("s_waitcnt lgkmcnt(0)" ::: "memory");
            const float* sg = a->in[I_SUBLN];
            float gsub[4];
#pragma unroll
            for (int e = 0; e < 4; ++e) gsub[e] = sg[32 * e + r32e];
            LAS unsigned char* tb = lds + wid * 4096;
            const int lane_e = r32e + 32 * hie;
#pragma unroll
            for (int hf = 0; hf < 2; ++hf) {
#pragma unroll
                for (int r = 0; r < 16; ++r) { const float rs = scr[crow(r, hie)];
#pragma unroll
                    for (int e2 = 0; e2 < 2; ++e2) *(LAS unsigned short*)(tb + crow(r, hie) * 128 + (32 * e2 + r32e) * 2) = (unsigned short)(pk2(o[2 * hf + e2][r] * rs * gsub[2 * hf + e2], 0.f) & 0xffff); }
                asm volatile("s_waitcnt lgkmcnt(0)" ::: "memory");
#pragma unroll
                for (int k = 0; k < 4; ++k) { const int idx = k * 64 + lane_e, row = idx >> 3, ch = idx & 7;
                    const u32x4 v = *(const LAS u32x4*)(tb + row * 128 + ch * 16);
                    *(u32x4*)(MIXED + (tokb + q0 + row) * DM + 1024 + h * 128 + hf * 64 + ch * 8) = v; }
                asm volatile("s_waitcnt lgkmcnt(0)" ::: "memory");
            }
        }
        __syncthreads();
    }
}

constexpr int NPHASE = 17;
__global__ void __launch_bounds__(512, 2) fwd_kernel(Args a_unused) {
    extern __shared__ __attribute__((aligned(16))) unsigned char lds_raw[];
    const KA a0 = (KA)__builtin_amdgcn_kernarg_segment_ptr(); KA a = a0;
    LAS unsigned char* lds = (LAS unsigned char*)lds_raw;
    const int wave = __builtin_amdgcn_readfirstlane((int)threadIdx.x >> 6);
    const int lane = lane_id_v(), tid = wave * 64 + lane;
    const int G = gridDim.x, bx = blockIdx.x;
    const int vcu = (G % 8 == 0) ? (bx % 8) * (G / 8) + bx / 8 : bx;
    const int gw = vcu * 8 + wave, NGW = G * 8;
    unsigned* ctl = (unsigned*)(a->ws + WS_CTL);
    volatile LAS unsigned* MISC = (volatile LAS unsigned*)(lds + LDSCTL_OFF);
    for (int u = tid; u < (LDS_BYTES - LDSCTL_OFF) / 4; u += 512) ((LAS unsigned*)(lds + LDSCTL_OFF))[u] = 0u;
    __syncthreads();
    XcdBarrier bar; bar.bar = ctl + CW_BAR; bar.x = 0; bar.st = nullptr;
    if (!MK_MULTI) bar = xcd_barrier_post(ctl + CW_BAR, MISC + 8, tid == 0);
    const int lo = a->ph_lo, hi = a->ph_hi;
#ifndef PH_MASK
#define PH_MASK 0x1ffff
#endif
#define IN(k) (((PH_MASK >> (k)) & 1) && lo <= (k) && (k) < hi)
#define PH_BEGIN KA a = a0; asm volatile("" : "+s"(a)); const int lane = lane_id_v(), tid = wave * 64 + lane; (void)tid; (void)lane;
#ifndef DUP_MASK
#define DUP_MASK 0
#endif
#define REP(k) for (int rep_ = 0; rep_ < 1 + ((DUP_MASK >> (k)) & 1); ++rep_)
#define SEAM(k) do { if (!MK_MULTI && IN((k) + 1)) xcd_barrier(bar, wave == 0 && lane_id_v() == 0); } while (0)

    bf16_t* HN = (bf16_t*)(a->ws + WS_HN);
    float* H = a->out;

    if (IN(0)) { PH_BEGIN REP(0) {
        for (int u = bx; u < 256; u += G) s5_prep_unit(a, lds, u >> 1, u & 1, tid);
        LAS float* scr = (LAS float*)(lds + wave * 16896);
        constexpr int I0 = 32 * 160, I1 = 32 * 64, I2 = 32 * 352, I3 = 44 * 64, I4 = 16 * 128, I5 = 16 * 448, I6 = 56 * 64;
        constexpr int NITEMS = I0 + I1 + I2 + I3 + I4 + 8 * I5 + 8 * I6;
        for (int it = gw; it < NITEMS; it += NGW) {
            int r = it;
            if (r < I0) { p0_transpose_item(a->in[I_WIN], DM, MIX_IN, (bf16_t*)(a->ws + WS_WIN), 0, scr, r, lane); continue; } r -= I0;
            if (r < I1) { p0_transpose_item(a->in[I_WOUT], DM, DM, (bf16_t*)(a->ws + WS_WOUT), 0, scr, r, lane); continue; } r -= I1;
            if (r < I2) { p0_transpose_item(a->in[I_FFNGU], DM, 2 * DFF, (bf16_t*)(a->ws + WS_WGU), DFF, scr, r, lane, a->in[I_FFNNORM]); continue; } r -= I2;
            if (r < I3) { p0_transpose_item8(a->in[I_FFNDN], DFF, DM, a->ws + WS_WDN, 0, W8_DN_SCALE, scr, r, lane); continue; } r -= I3;
            if (r < I4) { p0_transpose_item8(a->in[I_GLUW], DM, 2 * DM, a->ws + WS_WGLU, DM, W8_GU_SCALE, scr, r, lane); continue; } r -= I4;
            if (r < 8 * I5) { const int e = r / I5; p0_transpose_item6(a->in[I_EGU] + (size_t)e * DM * 2 * DFE, DM, 2 * DFE, a->ws + WS_WEGU + (size_t)e * 2 * DFE * DM, DFE, scr, r % I5, lane); continue; } r -= 8 * I5;
            { const int e = r / I6; p0_transpose_item8(a->in[I_EDN] + (size_t)e * DFE * DM, DFE, DM, a->ws + WS_WEDN + (size_t)e * DM * DFE, 0, W8_DN_SCALE, scr, r % I6, lane); }
        }
        { const float* src = a->in[I_GMWS]; bf16_t* dst = (bf16_t*)(a->ws + WS_GMWS);
          for (int i = bx * 512 + tid; i < 4 * 128 * 128 / 2; i += G * 512) ((unsigned*)dst)[i] = pk2(src[2 * i], src[2 * i + 1]); }
        rmsnorm_rows_bf16(a->in[I_X], a->in[I_MIXNORM_E], HN, gw, NGW, lane);
        }
        SEAM(0);
    }
    if (IN(1)) { PH_BEGIN REP(1) {
        pg8::Gemm g{HN, (const bf16_t*)(a->ws + WS_WIN), DM, DM, DM}; pg8::GridOrder S; S.init(M / 256, MIX_IN / 256, G, bx);
        pg8::EpiProj E{(bf16_t*)(a->ws + WS_PROJ)};
        pg8::gemm_phase(lds, g, S, E, wave);
        }
        SEAM(1);
    }
    if (IN(2)) { PH_BEGIN
        float lam;
        { const float sa = wave_sum(a->in[I_LQ1][lane] * a->in[I_LK1][lane]), sb = wave_sum(a->in[I_LQ2][lane] * a->in[I_LK2][lane]); lam = expf(sa) - expf(sb) + 0.2f; }
        for (int u = vcu; u < 1024; u += G) { const int bh = u >> 3; attn_unit(a, lds, bh >> 3, bh & 7, u & 7, lam, wave * 64 + lane_id_v()); }
    }
    if (IN(2)) { PH_BEGIN
        gating_phase(a, lds, vcu, G, tid);
        SEAM(2);
    }
#if (DUP_MASK >> 2) & 1
    if (IN(2)) { PH_BEGIN
        float lam;
        { const float sa = wave_sum(a->in[I_LQ1][lane] * a->in[I_LK1][lane]), sb = wave_sum(a->in[I_LQ2][lane] * a->in[I_LK2][lane]); lam = expf(sa) - expf(sb) + 0.2f; }
        for (int u = vcu; u < 1024; u += G) { const int bh = u >> 3; attn_unit(a, lds, bh >> 3, bh & 7, u & 7, lam, tid); }
        SEAM(2);
    }
#endif
#if (DUP_MASK >> 17) & 1
    if (IN(2)) { PH_BEGIN
        gating_phase(a, lds, vcu, G, tid);
        SEAM(2);
    }
#endif
    if (IN(3)) { PH_BEGIN REP(3) {
        pg8::Gemm g{(const bf16_t*)(a->ws + WS_MIXED), (const bf16_t*)(a->ws + WS_WOUT), DM, DM, DM}; pg8::GridOrder S; S.init(M / 256, DM / 256, G, bx);
        pg8::EpiResSq E{a->in[I_X], a->ws};
        pg8::gemm_phase(lds, g, S, E, wave);
        }
        SEAM(3);
    }
    if (IN(5)) { PH_BEGIN REP(5) {
        pg8::Gemm g{HN, (const bf16_t*)(a->ws + WS_WGU), DM, DM, DM}; pg8::GridOrder S; S.init(M / 256, 2 * DFF / 256, G, bx);
        int pmA = -1, pmB = -1; bool two_ok = true;
        { pg8::Unit uu; for (int i = 0; S.next(i, uu); ++i) { if (pmA < 0) pmA = uu.pm; else if (uu.pm != pmA) { if (pmB < 0) pmB = uu.pm; else if (uu.pm != pmB) two_ok = false; } } if (pmB < 0) pmB = pmA; }
        LAS float* rst = (LAS float*)(lds + 131072);
        { const int tb_ = tid >> 8, rw_ = tid & 255; const int pm_ = tb_ ? pmB : pmA;
          if (pm_ >= 0) { const f32x4* sp = (const f32x4*)((const float*)(a->ws + WS_SL) + (size_t)(pm_ * 256 + rw_) * 32); float t_ = 0.f;
#pragma unroll
            for (int k = 0; k < 8; ++k) { const f32x4 q4 = sp[k]; t_ += (q4[0] + q4[1]) + (q4[2] + q4[3]); }
            rst[tid] = two_ok ? rsqrtf(t_ * (1.f / DM) + EPS) : __builtin_nanf(""); } }
        __syncthreads();
        pg8::EpiSwiGLUr8<1 << 20> E{a->ws + WS_ACT, DFF, rst, pmA, A8_FFN_SCALE};
        pg8::gemm_phase(lds, g, S, E, wave);
        }
        SEAM(5);
    }
    if (IN(6)) { PH_BEGIN
        pg8::Gemm g{(const bf16_t*)(a->ws + WS_ACT), (const bf16_t*)(a->ws + WS_WDN), DFF / 2, DFF / 2, DFF / 2}; pg8::GridOrder S; S.init(M / 256, DM / 256, G, bx, 1);
#if (DUP_MASK >> 6) & 1
        { pg8::EpiResF32 E2{H, (float*)(a->ws + WS_XP)}; pg8::gemm_phase(lds, g, S, E2, wave); }
#endif
        pg8::EpiResBf E{HN, 1.f / (W8_DN_SCALE * A8_FFN_SCALE)};
        pg8::gemm_phase<1>(lds, g, S, E, wave);
        SEAM(6);
    }
    if (IN(7)) { PH_BEGIN REP(7) {
        bf16_t* UA = (bf16_t*)(a->ws + WS_UA);
        LAS float* gl = (LAS float*)lds;
        for (int i = tid; i < DM / 4; i += 512) ((LAS f32x4*)gl)[i] = ((const f32x4*)a->in[I_MIXNORM_O])[i];
        __syncthreads();
        const int gq = lane >> 3, t = (lane >> 1) & 3, hf = lane & 1;
        for (int m0 = gw * 4; m0 < M; m0 += NGW * 4) {
            const int m = m0 + t;
            const bf16_t* xr = HN + (size_t)m * DM + gq * 16 + hf * 8;
            u32x4 x[16]; float sq_ = 0.f;
#pragma unroll
            for (int j = 0; j < 16; ++j) x[j] = *(const u32x4*)(xr + j * 128);
#pragma unroll
            for (int j = 0; j < 16; ++j) { const u32x4 p = x[j];
                const float a0 = bflo(p.x), a1 = bfhi(p.x), a2 = bflo(p.y), a3 = bfhi(p.y), a4 = bflo(p.z), a5 = bfhi(p.z), a6 = bflo(p.w), a7 = bfhi(p.w);
                sq_ += ((a0 * a0 + a1 * a1) + (a2 * a2 + a3 * a3)) + ((a4 * a4 + a5 * a5) + (a6 * a6 + a7 * a7)); }
            sq_ += swz_xor<1>(sq_); sq_ += swz_xor<8>(sq_); sq_ += swz_xor<16>(sq_); sq_ = half_sum(sq_);
            const float rstd = rsqrtf(sq_ * (1.f / DM) + EPS);
            const int b = m >> 11, sqn = m & 2047, ch = sqn >> 5, sp = sqn & 31;
            bf16_t* up = UA + ((size_t)gq * 1024 + b * 64 + ch) * S5K + sp * 16 + hf * 8;
            unsigned go_ = (unsigned)(gq * 16 + hf * 8) * 4u; asm volatile("" : "+v"(go_));
            const LAS unsigned char* glb = (const LAS unsigned char*)gl + go_;
#pragma unroll
            for (int j = 0; j < 16; ++j) { const u32x4 p = x[j]; const f32x4 g0 = *(const LAS f32x4*)(glb + j * 512), g1 = *(const LAS f32x4*)(glb + j * 512 + 16);
                u32x4 w; w.x = pk2(bflo(p.x) * rstd * g0.x, bfhi(p.x) * rstd * g0.y); w.y = pk2(bflo(p.y) * rstd * g0.z, bfhi(p.y) * rstd * g0.w);
                w.z = pk2(bflo(p.z) * rstd * g1.x, bfhi(p.z) * rstd * g1.y); w.w = pk2(bflo(p.w) * rstd * g1.z, bfhi(p.w) * rstd * g1.w);
                *(u32x4*)(up + (size_t)(8 * j) * 1024 * S5K) = w;
                if ((j & 3) == 3) __builtin_amdgcn_sched_barrier(0); }
        }
        }
        __syncthreads();
        SEAM(7);
    }
    if (IN(8)) { PH_BEGIN REP(8) {
        pg8::Gemm g{(const bf16_t*)(a->ws + WS_UA), (const bf16_t*)(a->ws + WS_S5BZ), S5K, 512, 512}; pg8::BatchOrder<4, 1> S; S.init(S5G, G, bx);
        pg8::EpiZ E{(bf16_t*)(a->ws + WS_Z)};
        pg8::gemm_phase(lds, g, S, E, wave);
        }
        SEAM(8);
    }
    if (IN(9)) { PH_BEGIN REP(9) {
        const bf16_t* Z = (const bf16_t*)(a->ws + WS_Z); bf16_t* UA = (bf16_t*)(a->ws + WS_UA);
        for (int id = bx * 512 + tid; id < S5G * NB * 128; id += G * 512) {
            const int p = id & 63, d = (id >> 6) & 1, b = (id >> 7) & 15, g = id >> 11;
            const float dt = expf(a->in[I_LOGDT][d * S5G + g]);
            const float ar = a->in[I_LAMRE][(d * S5G + g) * 64 + p] * dt, ai = a->in[I_LAMIM][(d * S5G + g) * 64 + p] * dt;
            const float mag = expf(32.f * ar); const double rev = 32.0 * (double)ai * 0.15915494309189535; const float fr = (float)(rev - rint(rev));
            const float lr = mag * __builtin_amdgcn_cosf(fr), li = mag * __builtin_amdgcn_sinf(fr);
            float sr = 0.f, si = 0.f;
            const size_t row0 = (size_t)g * 1024 + b * 64;
            const bf16_t* zp = Z + (row0 + (d ? 63 : 0)) * 256 + d * 128 + 2 * p; bf16_t* up = UA + (row0 + (d ? 63 : 0)) * S5K + 512 + d * 128 + 2 * p;
            const long zstep = d ? -256 : 256, ustep = d ? -(long)S5K : (long)S5K;
#pragma unroll 1
            for (int hb = 0; hb < 4; ++hb) {
                f32x2 zz[16];
#pragma unroll
                for (int i = 0; i < 16; ++i) { const unsigned zw = *(const unsigned*)(zp + (hb * 16 + i) * zstep); zz[i] = (f32x2){bflo(zw), bfhi(zw)}; }
#pragma unroll
                for (int i = 0; i < 16; ++i) {
                    *(unsigned*)(up + (hb * 16 + i) * ustep) = pk2(sr, si);
                    const float nr = lr * sr - li * si + zz[i].x, ni = lr * si + li * sr + zz[i].y; sr = nr; si = ni; }
            }
        }
        }
        SEAM(9);
    }
    if (IN(10)) { PH_BEGIN REP(10) {
        pg8::Gemm g{(const bf16_t*)(a->ws + WS_UA), (const bf16_t*)(a->ws + WS_S5BY), S5K, S5K, S5K}; pg8::BatchOrder<4, 2> S; S.init(S5G, G, bx);
        pg8::EpiS5Y E{a->ws + WS_YG};
        pg8::gemm_phase(lds, g, S, E, wave);
        }
        SEAM(10);
    }
    if (IN(11)) { PH_BEGIN
        pg8::Gemm g{(const bf16_t*)(a->ws + WS_YG), (const bf16_t*)(a->ws + WS_WGLU), DM / 2, DM / 2, DM / 2}; pg8::GridOrder S; S.init(M / 256, 2 * DM / 256, G, bx);
#if (DUP_MASK >> 11) & 1
        { pg8::EpiGLU E2{(bf16_t*)(a->ws + WS_UA), 1.f}; pg8::gemm_phase<1>(lds, g, S, E2, wave); }
#endif
        pg8::EpiGLU E{HN, 1.f / (W8_GU_SCALE * Y8_SCALE)};
        pg8::gemm_phase<1>(lds, g, S, E, wave);
        SEAM(11);
    }
    if (IN(12)) { PH_BEGIN REP(12) {
        unsigned char* HN2 = a->ws + WS_HN2; const float* RW = a->in[I_ROUTER]; unsigned char* RT = a->ws + WS_ROUTE;
        f32x4 gv[8];
#pragma unroll
        for (int j = 0; j < 8; ++j) gv[j] = ((const f32x4*)a->in[I_MOENORM])[lane + 64 * j];
        int cnt[NEXP];
#pragma unroll
        for (int e = 0; e < NEXP; ++e) cnt[e] = 0;
        LAS float* RWt = (LAS float*)(lds + 8 * 9216);
        for (int i = tid; i < DM * NEXP / 4; i += 512) { const f32x4 w4 = ((const f32x4*)RW)[i]; const int col = i >> 1, e0 = (i & 1) * 4;
            RWt[(e0 + 0) * DM + col] = w4.x; RWt[(e0 + 1) * DM + col] = w4.y; RWt[(e0 + 2) * DM + col] = w4.z; RWt[(e0 + 3) * DM + col] = w4.w; }
        __syncthreads();
        u32x2 vnx[8];
        if (gw < M) { const u32x2* xr = (const u32x2*)(HN + (size_t)gw * DM) + lane;
#pragma unroll
            for (int j = 0; j < 8; ++j) vnx[j] = xr[64 * j]; }
        for (int m = gw; m < M; m += NGW) {
            f32x4 v[8]; float sq_ = 0.f;
#pragma unroll
            for (int j = 0; j < 8; ++j) { v[j] = (f32x4){bflo(vnx[j].x), bfhi(vnx[j].x), bflo(vnx[j].y), bfhi(vnx[j].y)}; sq_ += (v[j].x * v[j].x + v[j].y * v[j].y) + (v[j].z * v[j].z + v[j].w * v[j].w); }
            if (m + NGW < M) { const u32x2* xr = (const u32x2*)(HN + (size_t)(m + NGW) * DM) + lane;
#pragma unroll
                for (int j = 0; j < 8; ++j) vnx[j] = xr[64 * j]; }
            const float rstd = rsqrtf(wave_sum(sq_) * (1.f / DM) + EPS);
            float lg[NEXP];
#pragma unroll
            for (int e = 0; e < NEXP; ++e) lg[e] = 0.f;
            LAS float* tb = (LAS float*)(lds + wave * 9216);
#pragma unroll
            for (int j = 0; j < 8; ++j) {
                const float t0 = v[j].x * rstd * gv[j].x, t1 = v[j].y * rstd * gv[j].y, t2 = v[j].z * rstd * gv[j].z, t3 = v[j].w * rstd * gv[j].w;
                *(LAS f32x4*)(tb + ((lane >> 3) + 8 * j) * 36 + 4 * (lane & 7)) = (f32x4){t0, t1, t2, t3};
#pragma unroll
                for (int e = 0; e < NEXP; ++e) { const f32x4 w4 = *(const LAS f32x4*)(RWt + e * DM + 4 * lane + 256 * j);
                    lg[e] += t0 * w4.x; lg[e] += t1 * w4.y; lg[e] += t2 * w4.z; lg[e] += t3 * w4.w; }
            }
            { float x[32];
#pragma unroll
              for (int q = 0; q < 8; ++q) { const f32x4 t4 = *(const LAS f32x4*)(tb + lane * 36 + 4 * q); x[4 * q] = t4.x; x[4 * q + 1] = t4.y; x[4 * q + 2] = t4.z; x[4 * q + 3] = t4.w; }
              u32x6 pk; unsigned sb; quant_fp6_block(x, pk, sb);
              unsigned char* dst = HN2 + (size_t)m * DM + (lane >> 2) * 128 + (lane & 3) * 16;
              *(u32x4*)dst = (u32x4){pk[0], pk[1], pk[2], pk[3]}; *(u32x4*)(dst + 64) = (u32x4){pk[4], pk[5], sb, 0u}; }
#pragma unroll
            for (int e = 0; e < NEXP; ++e) lg[e] = wave_sum(lg[e]);
            int e1 = 0; float v1 = lg[0];
#pragma unroll
            for (int e = 1; e < NEXP; ++e) if (lg[e] > v1) { v1 = lg[e]; e1 = e; }
            int e2 = -1; float v2 = -3.0e38f;
#pragma unroll
            for (int e = 0; e < NEXP; ++e) if (e != e1 && lg[e] > v2) { v2 = lg[e]; e2 = e; }
            const float g1 = 1.f / (1.f + expf(v2 - v1)), g2 = 1.f - g1;
            if (lane == 0) { int* ri = (int*)(RT + (size_t)m * 24); ri[0] = e1; ri[1] = e2; ((float*)ri)[2] = g1; ((float*)ri)[3] = g2; }
#pragma unroll
            for (int e = 0; e < NEXP; ++e) cnt[e] += (e == e1 || e == e2) ? 1 : 0;
        }
        if (lane == 0 && rep_ == 0) {
#pragma unroll
            for (int e = 0; e < NEXP; ++e) if (cnt[e]) __hip_atomic_fetch_add(ctl + CW_ECNT + 64 * e, (unsigned)cnt[e], __ATOMIC_RELAXED, __HIP_MEMORY_SCOPE_AGENT);
        }
        }
        SEAM(12);
    }
    int ts[NEXP + 1];
    if (IN(13) || IN(14) || IN(15)) {
        ts[0] = 0;
#pragma unroll
        for (int e = 0; e < NEXP; ++e) { const unsigned c = __builtin_amdgcn_readfirstlane(__hip_atomic_load(ctl + CW_ECNT + 64 * e, __ATOMIC_RELAXED, __HIP_MEMORY_SCOPE_AGENT)); ts[e + 1] = ts[e] + (int)((c + 255u) >> 8); }
    }
    if (IN(13)) { PH_BEGIN
        unsigned char* RT = a->ws + WS_ROUTE; const unsigned char* HN2 = a->ws + WS_HN2; unsigned char* XP = a->ws + WS_XP;
        LAS int* slots = (LAS int*)lds;
        for (int blk = bx; blk < M / 128; blk += G) {
            if (wave < 2) {
                const int m = blk * 128 + wave * 64 + lane; int* ri = (int*)(RT + (size_t)m * 24);
                const int e1 = ri[0], e2 = ri[1]; int s1 = 0, s2 = 0;
#pragma unroll
                for (int e = 0; e < NEXP; ++e) {
                    const unsigned long long m1 = __ballot(e1 == e), m2 = __ballot(e2 == e);
                    const int c1 = __popcll(m1), c2 = __popcll(m2);
                    unsigned base = 0;
                    if (lane == 0 && (c1 + c2)) base = __hip_atomic_fetch_add(ctl + CW_EFILL + 64 * e, (unsigned)(c1 + c2), __ATOMIC_RELAXED, __HIP_MEMORY_SCOPE_AGENT);
                    base = (unsigned)__builtin_amdgcn_readfirstlane((int)base);
                    const unsigned long long lt = (1ull << lane) - 1ull;
                    if (e1 == e) s1 = ts[e] * 256 + (int)base + __popcll(m1 & lt);
                    if (e2 == e) s2 = ts[e] * 256 + (int)base + c1 + __popcll(m2 & lt);
                }
                ri[4] = s1; ri[5] = s2;
                slots[(wave * 64 + lane) * 2] = s1; slots[(wave * 64 + lane) * 2 + 1] = s2;
            }
            __syncthreads();
            { u32x4 xr[16][2];
#pragma unroll
              for (int i = 0; i < 16; ++i) { const u32x4* src = (const u32x4*)(HN2 + (size_t)(blk * 128 + wave * 16 + i) * DM) + lane; xr[i][0] = src[0]; xr[i][1] = src[64]; }
#pragma unroll
              for (int i = 0; i < 16; ++i) { const int tl = wave * 16 + i; const int s1 = slots[tl * 2], s2 = slots[tl * 2 + 1];
                u32x4* d1 = (u32x4*)(XP + (size_t)s1 * DM) + lane; u32x4* d2 = (u32x4*)(XP + (size_t)s2 * DM) + lane;
                d1[0] = xr[i][0]; d1[64] = xr[i][1]; d2[0] = xr[i][0]; d2[64] = xr[i][1]; } }
            __syncthreads();
        }
        SEAM(13);
    }
    if (IN(14)) { PH_BEGIN REP(14) {
        pg8::Gemm g{(const bf16_t*)(a->ws + WS_XP), (const bf16_t*)(a->ws + WS_WEGU), DM / 2, DM / 2, DM / 2};
        pg8::MoeOrder<56> S; S.go.init(ts[NEXP], 56, G, bx);
#pragma unroll
        for (int e = 0; e <= NEXP; ++e) S.ts[e] = ts[e];
        pg8::EpiSwiGLU8<56> E{a->ws + WS_ACTM, DFE, 1.f};
        pg8::gemm_phase<2>(lds, g, S, E, wave);
        }
        SEAM(14);
    }
    if (IN(15)) { PH_BEGIN REP(15) {
        const int TM = (G == 256 && ts[NEXP] > 256) ? 256 : ts[NEXP];
        { pg8::Gemm g{(const bf16_t*)(a->ws + WS_ACTM), (const bf16_t*)(a->ws + WS_WEDN), DFE / 2, DFE / 2, DFE / 2};
          pg8::MoeOrder<8> S; S.go.init(TM, 8, G, bx, 1);
#pragma unroll
          for (int e = 0; e <= NEXP; ++e) S.ts[e] = ts[e];
          pg8::EpiBf16Plain<8> E{(bf16_t*)(a->ws + WS_YP), DM, 1.f / W8_DN_SCALE};
          pg8::gemm_phase<1>(lds, g, S, E, wave); }
        { const int nq = (ts[NEXP] - TM) * 32;
          const int qu = bx;
          if (qu < nq) {
            const int pm = TM + (qu >> 5), pnl = (qu >> 2) & 7, q = qu & 3; int e = 0;
#pragma unroll
            for (int k = 1; k < NEXP; ++k) e += (pm >= ts[k]) ? 1 : 0;
            pg8::Gemm g{(const bf16_t*)(a->ws + WS_ACTM + (size_t)q * (DFE / 4)), (const bf16_t*)(a->ws + WS_WEDN + (size_t)q * (DFE / 4)), DFE / 2, DFE / 2, DFE / 8};
            pg8::ListOrder S{pm, e * 8 + pnl, 1};
            pg8::EpiPartF32 E{(float*)(a->ws + WS_XP) + (size_t)q * 2048 * DM, TM, 1.f / W8_DN_SCALE};
            pg8::gemm_phase<1>(lds, g, S, E, wave);
          } }
        }
        SEAM(15);
    }
    if (IN(16)) { PH_BEGIN
        const unsigned char* RT = a->ws + WS_ROUTE; const bf16_t* YP = (const bf16_t*)(a->ws + WS_YP); const float* PART = (const float*)(a->ws + WS_XP); constexpr size_t PQ4 = (size_t)2048 * DM / 4;
        const unsigned tmo = __hip_atomic_load(ctl + CW_BAR + XB_TMO, __ATOMIC_RELAXED, __HIP_MEMORY_SCOPE_AGENT);
        int split0;
        { int tt = 0;
#pragma unroll
          for (int e = 0; e < NEXP; ++e) { const unsigned c = __builtin_amdgcn_readfirstlane(__hip_atomic_load(ctl + CW_ECNT + 64 * e, __ATOMIC_RELAXED, __HIP_MEMORY_SCOPE_AGENT)); tt += (int)((c + 255u) >> 8); }
          split0 = ((G == 256 && tt > 256) ? 256 : tt) * 256; }
        f32x4 gv[8];
#pragma unroll
        for (int j = 0; j < 8; ++j) gv[j] = ((const f32x4*)a->in[I_FINALNORM])[lane + 64 * j];
        for (int m = gw; m < M; m += NGW) {
            const int* ri = (const int*)(RT + (size_t)m * 24); const float g1 = ((const float*)ri)[2], g2 = ((const float*)ri)[3]; const int s1 = ri[4], s2 = ri[5];
            f32x4* hr = (f32x4*)(H + (size_t)m * DM) + lane; const u32x2* hb = (const u32x2*)(HN + (size_t)m * DM) + lane;
            f32x4 v[8], c1[8], c2[8]; float s = 0.f;
#define P16_ROW(S_, C_) do { if ((S_) < split0) { const u32x2* yp_ = (const u32x2*)(YP + (size_t)(S_) * DM) + lane; \
                _Pragma("unroll") for (int j = 0; j < 8; ++j) { const u32x2 p = yp_[64 * j]; C_[j] = (f32x4){bflo(p.x), bfhi(p.x), bflo(p.y), bfhi(p.y)}; } } \
              else { const f32x4* pp_ = (const f32x4*)(PART + (size_t)((S_) - split0) * DM) + lane; \
                _Pragma("unroll") for (int j = 0; j < 8; ++j) C_[j] = (pp_[64 * j] + pp_[64 * j + PQ4]) + (pp_[64 * j + 2 * PQ4] + pp_[64 * j + 3 * PQ4]); } } while (0)
            P16_ROW(s1, c1); P16_ROW(s2, c2);
#undef P16_ROW
#pragma unroll
            for (int j = 0; j < 8; ++j) { const u32x2 p = hb[64 * j]; const f32x4 x = (f32x4){bflo(p.x), bfhi(p.x), bflo(p.y), bfhi(p.y)};
                v[j] = x + c1[j] * g1 + c2[j] * g2;
                s += (v[j].x * v[j].x + v[j].y * v[j].y) + (v[j].z * v[j].z + v[j].w * v[j].w); }
            float rstd = rsqrtf(wave_sum(s) * (1.f / DM) + EPS);
            if (tmo) rstd = __builtin_nanf("");
#pragma unroll
            for (int j = 0; j < 8; ++j) hr[64 * j] = v[j] * rstd * gv[j];
        }
    }
#undef IN
#undef SEAM
}

extern "C" void kernel_launch(void* const* d_in, const int* in_sizes, int n_in, void* d_out, int out_size, void* d_ws, size_t ws_size, hipStream_t stream) {
    static int grid = 0;
    if (grid == 0) {
        if (n_in != 30 || out_size != M * DM || ws_size < WS_END) { fprintf(stderr, "kernel_launch: unexpected shapes: n_in %d out %d ws %zu (need %zu)\n", n_in, out_size, ws_size, (size_t)WS_END); grid = -1; return; }
        int dev = 0, cus = 0, per_cu = 0;
        if (hipGetDevice(&dev) != hipSuccess || hipDeviceGetAttribute(&cus, hipDeviceAttributeMultiprocessorCount, dev) != hipSuccess) { grid = -1; return; }
        if (hipFuncSetAttribute((const void*)fwd_kernel, hipFuncAttributeMaxDynamicSharedMemorySize, LDS_BYTES) != hipSuccess) { fprintf(stderr, "kernel_launch: hipFuncSetAttribute failed\n"); grid = -1; return; }
        if (hipOccupancyMaxActiveBlocksPerMultiprocessor(&per_cu, (const void*)fwd_kernel, 512, LDS_BYTES) != hipSuccess || per_cu < 1) fprintf(stderr, "kernel_launch: occupancy query reports %d\n", per_cu);
        (void)hipGetLastError();
        grid = cus;
    }
    if (grid < 0) return;
    (void)hipMemsetAsync((char*)d_ws + WS_CTL, 0, CTL_ZERO_BYTES, stream);
    Args a{};
    for (int i = 0; i < 30; ++i) a.in[i] = (const float*)d_in[i];
    a.out = (float*)d_out; a.ws = (unsigned char*)d_ws;
#if MK_MULTI
    for (int p = 0; p < NPHASE; ++p) { a.ph_lo = p; a.ph_hi = p + 1; hipLaunchKernelGGL(fwd_kernel, dim3(grid), dim3(512), LDS_BYTES, stream, a); }
#else
    a.ph_lo = 0; a.ph_hi = NPHASE;
    hipLaunchKernelGGL(fwd_kernel, dim3(grid), dim3(512), LDS_BYTES, stream, a);
#endif
}
```

```cpp
#include <hip/hip_runtime.h>
#include <cstdio>
#include <cstdint>

#ifndef MK_MULTI
#define MK_MULTI 0
#endif

#define LAS __attribute__((address_space(3)))
typedef unsigned short bf16_t;
typedef short bf16x8 __attribute__((ext_vector_type(8)));
typedef short s16x4 __attribute__((ext_vector_type(4)));
typedef float f32x2 __attribute__((ext_vector_type(2)));
typedef float f32x4 __attribute__((ext_vector_type(4)));
typedef float f32x16 __attribute__((ext_vector_type(16)));
typedef unsigned u32x2 __attribute__((ext_vector_type(2)));
typedef unsigned u32x4 __attribute__((ext_vector_type(4)));
typedef __bf16 bf16x2_t __attribute__((ext_vector_type(2)));
typedef int i32x4 __attribute__((ext_vector_type(4)));
typedef int i32x8 __attribute__((ext_vector_type(8)));
typedef unsigned u32x6 __attribute__((ext_vector_type(6)));

__device__ __forceinline__ unsigned pk2(float lo, float hi) { f32x2 v = {lo, hi}; bf16x2_t b = __builtin_convertvector(v, bf16x2_t); return __builtin_bit_cast(unsigned, b); }
__device__ __forceinline__ unsigned pk4_fp8(float a, float b, float c, float d) { int r = __builtin_amdgcn_cvt_pk_fp8_f32(a, b, 0, false); r = __builtin_amdgcn_cvt_pk_fp8_f32(c, d, r, true); return (unsigned)r; }
__device__ __forceinline__ void quant_fp6_block(const float (&x)[32], u32x6& pack, unsigned& sb) {
    float amax = 0.f;
#pragma unroll
    for (int i = 0; i < 32; ++i) amax = fmaxf(amax, fabsf(x[i]));
    int e = (int)((__float_as_uint(amax) >> 23) & 0xffu) - 2; e = e < 0 ? 0 : e;
    const float inv = __uint_as_float((unsigned)(254 - e) << 23);
    f32x16 lo, hi;
#pragma unroll
    for (int i = 0; i < 16; ++i) { lo[i] = x[i] * inv; hi[i] = x[16 + i] * inv; }
    pack = __builtin_bit_cast(u32x6, __builtin_amdgcn_cvt_scalef32_2xpk16_fp6_f32(lo, hi, 1.0f));
    sb = (unsigned)e;
}
__device__ __forceinline__ float bf2f(unsigned short b) { return __uint_as_float(((unsigned)b) << 16); }
__device__ __forceinline__ float bflo(unsigned w) { return __uint_as_float(w << 16); }
__device__ __forceinline__ float bfhi(unsigned w) { return __uint_as_float(w & 0xffff0000u); }
__device__ __forceinline__ float fast_sigmoid(float x) { return __builtin_amdgcn_rcpf(1.f + __builtin_amdgcn_exp2f(-1.4426950408889634f * x)); }
__device__ __forceinline__ float gelu_tanh(float x) { const float t = x * x, p = t * -0.1029432410f + -2.3022082f; return x * __builtin_amdgcn_rcpf(1.f + __builtin_amdgcn_exp2f(x * p)); }
__device__ __forceinline__ float silu_f(float x) { return x * fast_sigmoid(x); }
__device__ __forceinline__ f32x2 swiglu2(f32x2 g, f32x2 u, float ka, float c) {
    const f32x2 x = g * u, ea = g * ka; f32x2 e; e.x = __builtin_amdgcn_exp2f(ea.x); e.y = __builtin_amdgcn_exp2f(ea.y);
    const f32x2 d = e * c + c; f32x2 r; r.x = __builtin_amdgcn_rcpf(d.x); r.y = __builtin_amdgcn_rcpf(d.y);
    return x * r;
}
__device__ __forceinline__ int lane_id_v() { int l; asm volatile("v_mbcnt_lo_u32_b32 %0, -1, 0\n\tv_mbcnt_hi_u32_b32 %0, -1, %0" : "=v"(l)); return l; }
template <int M> __device__ __forceinline__ float swz_xor(float v) { return __int_as_float(__builtin_amdgcn_ds_swizzle(__float_as_int(v), 0x1F | (M << 10))); }
__device__ __forceinline__ float half_sum(float v) { auto rr = __builtin_amdgcn_permlane32_swap(__float_as_uint(v), __float_as_uint(v), false, false); return __uint_as_float(rr[0]) + __uint_as_float(rr[1]); }
__device__ __forceinline__ float half_max(float v) { auto rr = __builtin_amdgcn_permlane32_swap(__float_as_uint(v), __float_as_uint(v), false, false); return fmaxf(__uint_as_float(rr[0]), __uint_as_float(rr[1])); }
__device__ __forceinline__ float wave_sum(float v) {
    v += swz_xor<1>(v); v += swz_xor<2>(v); v += swz_xor<4>(v); v += swz_xor<8>(v); v += swz_xor<16>(v);
    return half_sum(v);
}

constexpr int DM = 2048, NB = 16, SEQ = 2048, M = NB * SEQ;
constexpr int MIX_IN = 5120, DFF = 5632, NEXP = 8, DFE = 7168;
constexpr int S5G = 128, S5L = 32, S5ROWS = S5G * 1024, S5K = 768;
constexpr int MOE_ROWS = 2 * M + NEXP * 256;
constexpr float EPS = 1e-6f;
constexpr float Y8_SCALE = 8.f;
constexpr float A8_FFN_SCALE = 8.f;
constexpr float W8_GU_SCALE = 64.f, W8_DN_SCALE = 128.f;
constexpr float QSCALE = 0.125f * 1.4426950408889634f;

constexpr size_t MiB = (size_t)1 << 20;
constexpr size_t WS_CTL = 0, CTL_ZERO_BYTES = 1 * MiB;
constexpr size_t WS_ROUTE = 1 * MiB;
constexpr size_t WS_GMWS = 2 * MiB;
constexpr size_t WS_SL = 3 * MiB;
constexpr size_t WS_WIN = 8 * MiB;
constexpr size_t WS_WOUT = WS_WIN + 20 * MiB;
constexpr size_t WS_WGU = WS_WOUT + 8 * MiB;
constexpr size_t WS_WDN = WS_WGU + 44 * MiB;
constexpr size_t WS_WGLU = WS_WDN + 22 * MiB;
constexpr size_t WS_WEGU = WS_WGLU + 16 * MiB;
constexpr size_t WS_WEDN = WS_WEGU + 448 * MiB;
constexpr size_t WS_S5BY = WS_WEDN + 224 * MiB;
constexpr size_t WS_S5BZ = WS_S5BY + 96 * MiB;
constexpr size_t WS_ACT0 = WS_S5BZ + 32 * MiB;
constexpr size_t WS_HN = WS_ACT0;
constexpr size_t WS_PROJ = WS_HN + 128 * MiB;
constexpr size_t WS_O0 = WS_PROJ + 320 * MiB;
constexpr size_t WS_MIXED = WS_O0 + 128 * MiB;
constexpr size_t WS_ACT = WS_PROJ;
constexpr size_t WS_UA = WS_HN + 128 * MiB;
constexpr size_t WS_Z = WS_UA + 192 * MiB;
constexpr size_t WS_YG = WS_Z + 128 * MiB;
constexpr size_t WS_HN2 = WS_YG + 128 * MiB;
constexpr size_t WS_XP = WS_HN2 + 128 * MiB;
constexpr size_t WS_ACTM = WS_XP + 264 * MiB;
constexpr size_t WS_YP = WS_UA;
constexpr size_t WS_END = WS_ACTM + 924 * MiB;
constexpr int CW_BAR = 4096;
constexpr int CW_ECNT = 16384;
constexpr int CW_EFILL = 16384 + 1024;

constexpr int SCR_BYTES = 155648;
constexpr int LDSCTL_OFF = SCR_BYTES;
constexpr int LDS_BYTES = 159744;

namespace pg8 {
constexpr int BM = 256, BK = 64, HALF = 128, HTB = HALF * BK * 2, STAGE_BYTES = 8 * HTB, NXCD = 8, WGM = 8;
__host__ __device__ __forceinline__ int lds_byte(int r, int c) { const int st = (r >> 4) * 2 + (c >> 5), rr = r & 15, cc = c & 31, ob = rr * 64 + cc * 2; return st * 1024 + (ob ^ (((ob >> 9) & 1) << 5)); }
__host__ __device__ __forceinline__ void stage_rc(int b, int& R, int& C) { const int st = b / 1024, sb = b % 1024, swz = sb ^ (((sb >> 9) & 1) << 5); R = (st >> 1) * 16 + swz / 64; C = (st & 1) * 32 + (swz % 64) / 2; }
__host__ __device__ __forceinline__ int perm32(int rho) { const int n = rho >> 4, i = rho & 15; return 8 * (i >> 2) + 4 * n + (i & 3); }

struct Unit { int pm, pn; };
struct Gemm { const bf16_t* A; const bf16_t* Bt; int lda, ldb, K; };

struct GridOrder {
    int nM, nN, nwg, G, c, rev;
    __device__ void init(int nM_, int nN_, int G_, int c_, int rev_ = 0) { nM = nM_; nN = nN_; nwg = nM * nN; G = G_; c = c_; rev = rev_; }
    __device__ __forceinline__ bool next(int i, Unit& u) const {
        const int ni = (nwg - c + G - 1) / G; if (i >= ni) return false;
        const long L = (long)(rev ? ni - 1 - i : i) * G + c;
        int wgid = (int)L; { const int q = nwg / NXCD, r = nwg % NXCD, xcd = wgid % NXCD, off = wgid / NXCD; wgid = (xcd < r ? xcd * (q + 1) : r * (q + 1) + (xcd - r) * q) + off; }
        const int nig = WGM * nN, gid = wgid / nig, fm = gid * WGM, gsz = (nM - fm) < WGM ? (nM - fm) : WGM;
        u.pm = fm + ((wgid % nig) % gsz); u.pn = (wgid % nig) / gsz; return true;
    }
    __device__ __forceinline__ void a_ready(const Unit&) const {}
    __device__ __forceinline__ void done(const Unit&) const {}
};
template <int RM, int RN> struct BatchOrder {
    int nwg, G, c;
    __device__ void init(int ngroups, int G_, int c_) { nwg = ngroups * RM * RN; G = G_; c = c_; }
    __device__ bool next(int i, Unit& u) const {
        const long L = (long)i * G + c; if (L >= nwg) return false;
        int wgid = (int)L; { const int q = nwg / NXCD, xcd = wgid % NXCD, off = wgid / NXCD; wgid = xcd * q + off; }
        const int g = wgid / (RM * RN), w = wgid % (RM * RN);
        u.pm = g * RM + (w % RM); u.pn = g * RN + (w / RM); return true;
    }
    __device__ __forceinline__ void a_ready(const Unit&) const {}
    __device__ __forceinline__ void done(const Unit&) const {}
};
struct ListOrder {
    int pm, pn0, n;
    __device__ bool next(int i, Unit& u) const { if (i >= n) return false; u.pm = pm; u.pn = pn0 + i; return true; }
    __device__ __forceinline__ void a_ready(const Unit&) const {}
    __device__ __forceinline__ void done(const Unit&) const {}
};
template <int NT> struct MoeOrder {
    GridOrder go; int ts[NEXP + 1];
    __device__ bool next(int i, Unit& u) const {
        if (!go.next(i, u)) return false;
        int e = 0;
#pragma unroll
        for (int k = 1; k < NEXP; ++k) e += (u.pm >= ts[k]) ? 1 : 0;
        u.pn += e * NT; return true;
    }
    __device__ __forceinline__ void a_ready(const Unit&) const {}
    __device__ __forceinline__ void done(const Unit&) const {}
};

struct EpiProj {
    static constexpr bool PERM = true; static constexpr int NVM = 16;
    bf16_t* O;
    __device__ __forceinline__ void operator()(const f32x4 (&acc)[2][2][4][2], const Unit& u, int wr, int wc, int fr, int fq) const {
        const int row0 = u.pm * BM + wr * 64 + fr, col0 = u.pn * BM + wc * 32 + 8 * fq;
        const int mode = (u.pn < 8) ? 1 : (u.pn < 12 ? 2 : 0);
#pragma unroll
        for (int ai = 0; ai < 2; ++ai)
#pragma unroll
            for (int m = 0; m < 4; ++m) { bf16_t* rowp = O + (size_t)(row0 + ai * HALF + m * 16) * MIX_IN + col0;
#pragma unroll
                for (int bj = 0; bj < 2; ++bj) { f32x4 v0 = acc[ai][bj][m][0], v1 = acc[ai][bj][m][1];
                    if (mode == 1) {
#pragma unroll
                        for (int j = 0; j < 4; ++j) { v0[j] = gelu_tanh(v0[j]); v1[j] = gelu_tanh(v1[j]); } }
                    else if (mode == 2) { v0 = v0 * QSCALE; v1 = v1 * QSCALE; }
                    u32x4 w; w.x = pk2(v0[0], v0[1]); w.y = pk2(v0[2], v0[3]); w.z = pk2(v1[0], v1[1]); w.w = pk2(v1[2], v1[3]);
                    *(u32x4*)(rowp + bj * HALF) = w; } }
    }
};
struct EpiResF32 {
    static constexpr bool PERM = false; static constexpr int NVM = 32;
    const float* res; float* out;
    __device__ __forceinline__ void operator()(const f32x4 (&acc)[2][2][4][2], const Unit& u, int wr, int wc, int fr, int fq) const {
        const int row0 = u.pm * BM + wr * 64 + fr, col0 = u.pn * BM + wc * 32 + 4 * fq;
        f32x4 r0[8], r1[8];
#define ER_OFF(G, mm) ((size_t)(row0 + ((G) >> 1) * HALF + (2 * ((G) & 1) + (mm)) * 16) * DM + col0)
#define ER_LOAD(G, R) do { _Pragma("unroll") for (int mm = 0; mm < 2; ++mm) _Pragma("unroll") for (int bj = 0; bj < 2; ++bj) _Pragma("unroll") for (int n = 0; n < 2; ++n) \
            R[mm * 4 + bj * 2 + n] = *(const f32x4*)(res + ER_OFF(G, mm) + bj * HALF + n * 16); } while (0)
#define ER_STORE(G, R) do { _Pragma("unroll") for (int mm = 0; mm < 2; ++mm) _Pragma("unroll") for (int bj = 0; bj < 2; ++bj) _Pragma("unroll") for (int n = 0; n < 2; ++n) \
            *(f32x4*)(out + ER_OFF(G, mm) + bj * HALF + n * 16) = R[mm * 4 + bj * 2 + n] + acc[(G) >> 1][bj][2 * ((G) & 1) + mm][n]; } while (0)
        ER_LOAD(0, r0); ER_LOAD(1, r1);
        ER_STORE(0, r0); ER_LOAD(2, r0);
        ER_STORE(1, r1); ER_LOAD(3, r1);
        ER_STORE(2, r0); ER_STORE(3, r1);
#undef ER_OFF
#undef ER_LOAD
#undef ER_STORE
    }
};
struct EpiResSq {
    static constexpr bool PERM = true; static constexpr int NVM = 32;
    const float* res; unsigned char* ws;
    __device__ __forceinline__ void operator()(const f32x4 (&acc)[2][2][4][2], const Unit& u, int wr, int wc, int fr, int fq) const {
        const int row0 = u.pm * BM + wr * 64 + fr, col0 = u.pn * BM + wc * 32 + 8 * fq;
        bf16_t* const hn = (bf16_t*)(ws + WS_HN); float* const sl = (float*)(ws + WS_SL);
        f32x4 r0[8], r1[8];
#define EQ_OFF(G, mm) ((size_t)(row0 + ((G) >> 1) * HALF + (2 * ((G) & 1) + (mm)) * 16) * DM + col0)
#define EQ_LOAD(G, R) do { _Pragma("unroll") for (int mm = 0; mm < 2; ++mm) _Pragma("unroll") for (int bj = 0; bj < 2; ++bj) _Pragma("unroll") for (int n = 0; n < 2; ++n) \
            R[mm * 4 + bj * 2 + n] = *(const f32x4*)(res + EQ_OFF(G, mm) + bj * HALF + n * 4); } while (0)
#define EQ_STORE(G, R) do { _Pragma("unroll") for (int mm = 0; mm < 2; ++mm) { float q_ = 0.f; _Pragma("unroll") for (int bj = 0; bj < 2; ++bj) { \
            const f32x4 o0 = R[mm * 4 + bj * 2] + acc[(G) >> 1][bj][2 * ((G) & 1) + mm][0], o1 = R[mm * 4 + bj * 2 + 1] + acc[(G) >> 1][bj][2 * ((G) & 1) + mm][1]; \
            u32x4 w; w.x = pk2(o0[0], o0[1]); w.y = pk2(o0[2], o0[3]); w.z = pk2(o1[0], o1[1]); w.w = pk2(o1[2], o1[3]); *(u32x4*)(hn + EQ_OFF(G, mm) + bj * HALF) = w; \
            q_ += ((o0[0] * o0[0] + o0[1] * o0[1]) + (o0[2] * o0[2] + o0[3] * o0[3])) + ((o1[0] * o1[0] + o1[1] * o1[1]) + (o1[2] * o1[2] + o1[3] * o1[3])); } \
            q_ += swz_xor<16>(q_); q_ = half_sum(q_);                                                          \
            if (fq == 0) sl[(size_t)(row0 + ((G) >> 1) * HALF + (2 * ((G) & 1) + mm) * 16) * 32 + u.pn * 4 + wc] = q_; } } while (0)
        EQ_LOAD(0, r0); EQ_LOAD(1, r1);
        EQ_STORE(0, r0); EQ_LOAD(2, r0);
        EQ_STORE(1, r1); EQ_LOAD(3, r1);
        EQ_STORE(2, r0); EQ_STORE(3, r1);
#undef EQ_LOAD
#undef EQ_STORE
#undef EQ_OFF
    }
};
struct EpiResBf {
    static constexpr bool PERM = true; static constexpr int NVM = 32;
    bf16_t* io; float s;
    __device__ __forceinline__ void operator()(const f32x4 (&acc)[2][2][4][2], const Unit& u, int wr, int wc, int fr, int fq) const {
        const int row0 = u.pm * BM + wr * 64 + fr, col0 = u.pn * BM + wc * 32 + 8 * fq;
        u32x4 r[16];
#pragma unroll
        for (int ai = 0; ai < 2; ++ai)
#pragma unroll
            for (int m = 0; m < 4; ++m)
#pragma unroll
                for (int bj = 0; bj < 2; ++bj) r[ai * 8 + m * 2 + bj] = *(const u32x4*)(io + (size_t)(row0 + ai * HALF + m * 16) * DM + col0 + bj * HALF);
#pragma unroll
        for (int ai = 0; ai < 2; ++ai)
#pragma unroll
            for (int m = 0; m < 4; ++m)
#pragma unroll
                for (int bj = 0; bj < 2; ++bj) { const u32x4 w = r[ai * 8 + m * 2 + bj]; bf16_t* op = io + (size_t)(row0 + ai * HALF + m * 16) * DM + col0 + bj * HALF;
                    const f32x4 a0 = acc[ai][bj][m][0] * s, a1 = acc[ai][bj][m][1] * s; u32x4 o;
                    o.x = pk2(a0[0] + bflo(w.x), a0[1] + bfhi(w.x)); o.y = pk2(a0[2] + bflo(w.y), a0[3] + bfhi(w.y));
                    o.z = pk2(a1[0] + bflo(w.z), a1[1] + bfhi(w.z)); o.w = pk2(a1[2] + bflo(w.w), a1[3] + bfhi(w.w));
                    *(u32x4*)op = o; }
    }
};
template <int NT> struct EpiSwiGLU {
    static constexpr bool PERM = true; static constexpr int NVM = 8;
    bf16_t* O; int ldo; const LAS float* rst; int pmA;
    __device__ __forceinline__ void operator()(const f32x4 (&acc)[2][2][4][2], const Unit& u, int wr, int wc, int fr, int fq) const {
        const int row0 = u.pm * BM + wr * 64 + fr, col0 = (u.pn % NT) * HALF + wc * 32 + 8 * fq;
        const LAS float* rt = rst + ((u.pm == pmA) ? 0 : 256) + wr * 64 + fr;
#pragma unroll
        for (int ai = 0; ai < 2; ++ai)
#pragma unroll
            for (int m = 0; m < 4; ++m) { bf16_t* rowp = O + (size_t)(row0 + ai * HALF + m * 16) * ldo + col0;
                const float rs = rt[ai * HALF + m * 16];
                const f32x4 g0 = acc[ai][0][m][0] * rs, g1 = acc[ai][0][m][1] * rs, u0 = acc[ai][1][m][0] * rs, u1 = acc[ai][1][m][1] * rs;
                const f32x2 a0 = swiglu2((f32x2){g0[0], g0[1]}, (f32x2){u0[0], u0[1]}, -1.4426950408889634f, 1.f), a1 = swiglu2((f32x2){g0[2], g0[3]}, (f32x2){u0[2], u0[3]}, -1.4426950408889634f, 1.f);
                const f32x2 a2 = swiglu2((f32x2){g1[0], g1[1]}, (f32x2){u1[0], u1[1]}, -1.4426950408889634f, 1.f), a3 = swiglu2((f32x2){g1[2], g1[3]}, (f32x2){u1[2], u1[3]}, -1.4426950408889634f, 1.f);
                u32x4 w; w.x = pk2(a0.x, a0.y); w.y = pk2(a1.x, a1.y); w.z = pk2(a2.x, a2.y); w.w = pk2(a3.x, a3.y);
                *(u32x4*)rowp = w; }
    }
};
template <int NT> struct EpiSwiGLUr8 {
    static constexpr bool PERM = true; static constexpr int NVM = 8;
    unsigned char* O; int ldo; const LAS float* rst; int pmA; float AS;
    __device__ __forceinline__ void operator()(const f32x4 (&acc)[2][2][4][2], const Unit& u, int wr, int wc, int fr, int fq) const {
        const int row0 = u.pm * BM + wr * 64 + fr, col0 = (u.pn % NT) * HALF + wc * 32 + 8 * fq;
        const LAS float* rt = rst + ((u.pm == pmA) ? 0 : 256) + wr * 64 + fr;
#pragma unroll
        for (int ai = 0; ai < 2; ++ai)
#pragma unroll
            for (int m = 0; m < 4; ++m) { unsigned char* rowp = O + (size_t)(row0 + ai * HALF + m * 16) * ldo + col0;
                const float rs = rt[ai * HALF + m * 16];
                const f32x4 g0 = acc[ai][0][m][0] * rs, g1 = acc[ai][0][m][1] * rs, u0 = acc[ai][1][m][0] * (rs * AS), u1 = acc[ai][1][m][1] * (rs * AS);
                const f32x2 a0 = swiglu2((f32x2){g0[0], g0[1]}, (f32x2){u0[0], u0[1]}, -1.4426950408889634f, 1.f), a1 = swiglu2((f32x2){g0[2], g0[3]}, (f32x2){u0[2], u0[3]}, -1.4426950408889634f, 1.f);
                const f32x2 a2 = swiglu2((f32x2){g1[0], g1[1]}, (f32x2){u1[0], u1[1]}, -1.4426950408889634f, 1.f), a3 = swiglu2((f32x2){g1[2], g1[3]}, (f32x2){u1[2], u1[3]}, -1.4426950408889634f, 1.f);
                u32x2 w; w.x = pk4_fp8(a0.x, a0.y, a1.x, a1.y); w.y = pk4_fp8(a2.x, a2.y, a3.x, a3.y);
                *(u32x2*)rowp = w; }
    }
};
struct EpiZ {
    static constexpr bool PERM = true; static constexpr int NVM = 16;
    bf16_t* out;
    __device__ __forceinline__ void operator()(const f32x4 (&acc)[2][2][4][2], const Unit& u, int wr, int wc, int fr, int fq) const {
        const int row0 = u.pm * BM + wr * 64 + fr, col0 = wc * 32 + 8 * fq;
#pragma unroll
        for (int ai = 0; ai < 2; ++ai)
#pragma unroll
            for (int m = 0; m < 4; ++m) { bf16_t* rowp = out + (size_t)(row0 + ai * HALF + m * 16) * 256 + col0;
#pragma unroll
                for (int bj = 0; bj < 2; ++bj) { const f32x4 v0 = acc[ai][bj][m][0], v1 = acc[ai][bj][m][1];
                    u32x4 w; w.x = pk2(v0[0], v0[1]); w.y = pk2(v0[2], v0[3]); w.z = pk2(v1[0], v1[1]); w.w = pk2(v1[2], v1[3]);
                    *(u32x4*)(rowp + bj * HALF) = w; } }
    }
};
struct EpiS5Y {
    static constexpr bool PERM = true; static constexpr int NVM = 16;
    unsigned char* O;
    __device__ __forceinline__ void operator()(const f32x4 (&acc)[2][2][4][2], const Unit& u, int wr, int wc, int fr, int fq) const {
        const int g = u.pm >> 2, brow0 = (u.pm & 3) * BM + wr * 64 + fr, ncol0 = (u.pn & 1) * BM + wc * 32 + 8 * fq;
#pragma unroll
        for (int ai = 0; ai < 2; ++ai)
#pragma unroll
            for (int m = 0; m < 4; ++m) { const int brow = brow0 + ai * HALF + m * 16, b = brow >> 6, ch = brow & 63;
#pragma unroll
                for (int bj = 0; bj < 2; ++bj) { const int n = ncol0 + bj * HALF, t = n >> 4, co = n & 15;
                    f32x4 v0 = acc[ai][bj][m][0], v1 = acc[ai][bj][m][1];
#pragma unroll
                    for (int j = 0; j < 4; ++j) { v0[j] = gelu_tanh(v0[j]) * Y8_SCALE; v1[j] = gelu_tanh(v1[j]) * Y8_SCALE; }
                    u32x2 w; w.x = pk4_fp8(v0[0], v0[1], v0[2], v0[3]); w.y = pk4_fp8(v1[0], v1[1], v1[2], v1[3]);
                    *(u32x2*)(O + (size_t)(b * SEQ + ch * S5L + t) * DM + g * 16 + co) = w; } }
    }
};
struct EpiGLU {
    static constexpr bool PERM = true; static constexpr int NVM = 16;
    bf16_t* io; float s;
    __device__ __forceinline__ void operator()(const f32x4 (&acc)[2][2][4][2], const Unit& u, int wr, int wc, int fr, int fq) const {
        const int row0 = u.pm * BM + wr * 64 + fr, col0 = u.pn * HALF + wc * 32 + 8 * fq;
        u32x4 r[8];
#pragma unroll
        for (int ai = 0; ai < 2; ++ai)
#pragma unroll
            for (int m = 0; m < 4; ++m) r[ai * 4 + m] = *(const u32x4*)(io + (size_t)(row0 + ai * HALF + m * 16) * DM + col0);
#pragma unroll
        for (int ai = 0; ai < 2; ++ai)
#pragma unroll
            for (int m = 0; m < 4; ++m) { const u32x4 w = r[ai * 4 + m]; const f32x4 v0 = acc[ai][0][m][0] * s, v1 = acc[ai][0][m][1] * s, g0 = acc[ai][1][m][0] * s, g1 = acc[ai][1][m][1] * s; u32x4 o;
                o.x = pk2(bflo(w.x) + v0[0] * fast_sigmoid(g0[0]), bfhi(w.x) + v0[1] * fast_sigmoid(g0[1])); o.y = pk2(bflo(w.y) + v0[2] * fast_sigmoid(g0[2]), bfhi(w.y) + v0[3] * fast_sigmoid(g0[3]));
                o.z = pk2(bflo(w.z) + v1[0] * fast_sigmoid(g1[0]), bfhi(w.z) + v1[1] * fast_sigmoid(g1[1])); o.w = pk2(bflo(w.w) + v1[2] * fast_sigmoid(g1[2]), bfhi(w.w) + v1[3] * fast_sigmoid(g1[3]));
                *(u32x4*)(io + (size_t)(row0 + ai * HALF + m * 16) * DM + col0) = o; }
    }
};
template <int NT> struct EpiSwiGLU8 {
    static constexpr bool PERM = true; static constexpr int NVM = 4;
    unsigned char* O; int ldo; float s;
    __device__ __forceinline__ void operator()(const f32x4 (&acc)[2][2][4][2], const Unit& u, int wr, int wc, int fr, int fq) const {
        const int row0 = u.pm * BM + wr * 64 + fr, col0 = (u.pn % NT) * HALF + wc * 32 + 8 * fq;
        const float ka = -1.4426950408889634f * s, c = 1.f / (s * s);
        unsigned char* rowp = O + (size_t)row0 * ldo + (col0 & ~15);
#pragma unroll
        for (int ai = 0; ai < 2; ++ai)
#pragma unroll
            for (int mp = 0; mp < 2; ++mp) {
                u32x2 w[2];
#pragma unroll
                for (int k = 0; k < 2; ++k) { const int m = 2 * mp + k;
                    const f32x4 g0 = acc[ai][0][m][0], g1 = acc[ai][0][m][1], u0 = acc[ai][1][m][0], u1 = acc[ai][1][m][1];
                    const f32x2 a0 = swiglu2((f32x2){g0[0], g0[1]}, (f32x2){u0[0], u0[1]}, ka, c), a1 = swiglu2((f32x2){g0[2], g0[3]}, (f32x2){u0[2], u0[3]}, ka, c);
                    const f32x2 a2 = swiglu2((f32x2){g1[0], g1[1]}, (f32x2){u1[0], u1[1]}, ka, c), a3 = swiglu2((f32x2){g1[2], g1[3]}, (f32x2){u1[2], u1[3]}, ka, c);
                    w[k].x = pk4_fp8(a0.x, a0.y, a1.x, a1.y); w[k].y = pk4_fp8(a2.x, a2.y, a3.x, a3.y); }
                const bool odd = fq & 1;
                const u32x2 snd = odd ? w[0] : w[1];
                u32x2 rcv; rcv.x = (unsigned)__builtin_amdgcn_ds_swizzle((int)snd.x, 0x1F | (16 << 10)); rcv.y = (unsigned)__builtin_amdgcn_ds_swizzle((int)snd.y, 0x1F | (16 << 10));
                const u32x4 v = odd ? (u32x4){rcv.x, rcv.y, w[1].x, w[1].y} : (u32x4){w[0].x, w[0].y, rcv.x, rcv.y};
                *(u32x4*)(rowp + (size_t)(ai * HALF + (2 * mp + (odd ? 1 : 0)) * 16) * ldo) = v; }
    }
};
template <int NT> struct EpiBf16Plain {
    static constexpr bool PERM = true; static constexpr int NVM = 16;
    bf16_t* O; int ldo; float s;
    __device__ __forceinline__ void operator()(const f32x4 (&acc)[2][2][4][2], const Unit& u, int wr, int wc, int fr, int fq) const {
        const int row0 = u.pm * BM + wr * 64 + fr, col0 = (u.pn % NT) * BM + wc * 32 + 8 * fq;
#pragma unroll
        for (int ai = 0; ai < 2; ++ai)
#pragma unroll
            for (int m = 0; m < 4; ++m) { bf16_t* rowp = O + (size_t)(row0 + ai * HALF + m * 16) * ldo + col0;
#pragma unroll
                for (int bj = 0; bj < 2; ++bj) { const f32x4 v0 = acc[ai][bj][m][0] * s, v1 = acc[ai][bj][m][1] * s;
                    u32x4 w; w.x = pk2(v0[0], v0[1]); w.y = pk2(v0[2], v0[3]); w.z = pk2(v1[0], v1[1]); w.w = pk2(v1[2], v1[3]);
                    *(u32x4*)(rowp + bj * HALF) = w; } }
    }
};

struct EpiPartF32 {
    static constexpr bool PERM = false; static constexpr int NVM = 32;
    float* out; int pm0; float s;
    __device__ __forceinline__ void operator()(const f32x4 (&acc)[2][2][4][2], const Unit& u, int wr, int wc, int fr, int fq) const {
        const int row0 = (u.pm - pm0) * BM + wr * 64 + fr, col0 = (u.pn & 7) * BM + wc * 32 + 4 * fq;
#pragma unroll
        for (int ai = 0; ai < 2; ++ai)
#pragma unroll
            for (int m = 0; m < 4; ++m) { float* rowp = out + (size_t)(row0 + ai * HALF + m * 16) * DM + col0;
#pragma unroll
                for (int bj = 0; bj < 2; ++bj)
#pragma unroll
                    for (int n = 0; n < 2; ++n) *(f32x4*)(rowp + bj * HALF + n * 16) = acc[ai][bj][m][n] * s; }
    }
};

template <int FMT = 0  , class Epi, class Sched>
__device__ __forceinline__ void gemm_phase(LAS unsigned char* lds, const Gemm g, const Sched& S, const Epi& E, const int wid) {
    const int lane = lane_id_v(), tid = wid * 64 + lane, wr = wid >> 2, wc = wid & 3, fr = lane & 15, fq = lane >> 4;
    const int K = g.K, nt = K / BK;
    unsigned voffA[2], voffB[2];
#pragma unroll
    for (int i = 0; i < 2; ++i) { int R, C; stage_rc(tid * 16 + i * 8192, R, C); const int Rb = Epi::PERM ? ((R & ~31) + perm32(R & 31)) : R;
        voffA[i] = (unsigned)(R * g.lda + C) * 2u; voffB[i] = (unsigned)(Rb * g.ldb + C) * 2u; }
    const size_t kstep = (size_t)(BK * 2);
    const size_t hsA = (size_t)HALF * g.lda * 2, hsB = (size_t)HALF * g.ldb * 2;
    const size_t tsA = 2 * hsA, tsB = 2 * hsB;
    const unsigned ldsw = (unsigned)wid * 1024u;
    const int aoff = lds_byte(wr * 64 + fr, fq * 8), boff = lds_byte(wc * 32 + fr, fq * 8);
    unsigned abase_u = (unsigned)(uintptr_t)lds + (unsigned)aoff, bbase_u = (unsigned)(uintptr_t)lds + (unsigned)(4 * HTB + boff);
    asm volatile("" : "+v"(abase_u), "+v"(bbase_u));
    const LAS unsigned char* abase = (const LAS unsigned char*)(uintptr_t)abase_u; const LAS unsigned char* bbase = (const LAS unsigned char*)(uintptr_t)bbase_u;
#define PG8_SA(b, h) (((b) * 2 + (h)) * HTB)
#define PG8_SB(b, h) ((4 + (b) * 2 + (h)) * HTB)
#define PG8_STAGE(bufoff, gbase, voff) do { _Pragma("unroll") for (int _i = 0; _i < 2; ++_i) { unsigned _vo = (voff)[_i]; asm volatile("" : "+v"(_vo));   \
        __builtin_amdgcn_global_load_lds((const unsigned*)((const char*)(gbase) + _vo), (LAS unsigned*)(lds + (bufoff) + ldsw + _i * 8192), 16, 0, 0); } } while (0)
#define PG8_RDA(off) (*(const LAS i32x4*)(abase + (off)))
#define PG8_RDB(off) (*(const LAS i32x4*)(bbase + (off)))
#define PG8_LDA(dst, b, h) do { _Pragma("unroll") for (int m = 0; m < 4; ++m) dst[m] = __builtin_shufflevector(PG8_RDA(PG8_SA(b, h) + m * 2048), PG8_RDA(PG8_SA(b, h) + m * 2048 + 1024), 0, 1, 2, 3, 4, 5, 6, 7); } while (0)
#define PG8_LDB(dst, b, h) do { _Pragma("unroll") for (int n = 0; n < 2; ++n) dst[n] = __builtin_shufflevector(PG8_RDB(PG8_SB(b, h) - 4 * HTB + n * 2048), PG8_RDB(PG8_SB(b, h) - 4 * HTB + n * 2048 + 1024), 0, 1, 2, 3, 4, 5, 6, 7); } while (0)
#define PG8_LO(x) __builtin_bit_cast(bf16x8, __builtin_shufflevector((x), (x), 0, 1, 2, 3))
#define PG8_HI(x) __builtin_bit_cast(bf16x8, __builtin_shufflevector((x), (x), 4, 5, 6, 7))
#define PG8_MMA(ai, bj, At, Bt) do { __builtin_amdgcn_s_setprio(1); _Pragma("unroll") for (int m = 0; m < 4; ++m) _Pragma("unroll") for (int n = 0; n < 2; ++n) { \
        if constexpr (FMT == 1) acc[ai][bj][m][n] = __builtin_amdgcn_mfma_scale_f32_16x16x128_f8f6f4(Bt[n], At[m], acc[ai][bj][m][n], 0, 0, 0, 0, 0, 0);   \
        else if constexpr (FMT == 2) acc[ai][bj][m][n] = __builtin_amdgcn_mfma_scale_f32_16x16x128_f8f6f4(Bt[n], At[m], acc[ai][bj][m][n], 2, 2, 0, Bt[n][6], 0, At[m][6]);   \
        else { acc[ai][bj][m][n] = __builtin_amdgcn_mfma_f32_16x16x32_bf16(PG8_LO(Bt[n]), PG8_LO(At[m]), acc[ai][bj][m][n], 0, 0, 0); \
               acc[ai][bj][m][n] = __builtin_amdgcn_mfma_f32_16x16x32_bf16(PG8_HI(Bt[n]), PG8_HI(At[m]), acc[ai][bj][m][n], 0, 0, 0); } } \
        __builtin_amdgcn_s_setprio(0); } while (0)
#define PG8_WAIT_V(n) asm volatile("s_waitcnt vmcnt(" #n ")" ::: "memory")
#define PG8_WAIT_L(n) asm volatile("s_waitcnt lgkmcnt(" #n ")" ::: "memory")
#define PG8_BAR __builtin_amdgcn_s_barrier()
#define PG8_SCHED __builtin_amdgcn_sched_barrier(0)
    Unit cur, nxt; int ui = 0;
    if (!S.next(0, cur)) return;
    f32x4 acc[2][2][4][2];
#pragma unroll
    for (int a = 0; a < 2; ++a)
#pragma unroll
        for (int b = 0; b < 2; ++b)
#pragma unroll
            for (int m = 0; m < 4; ++m)
#pragma unroll
                for (int n = 0; n < 2; ++n) acc[a][b][m][n] = (f32x4){0.f, 0.f, 0.f, 0.f};
    i32x8 At[4], B0[2], B1[2];
    const char* cA = (const char*)g.A + (size_t)cur.pm * tsA; const char* cB = (const char*)g.Bt + (size_t)cur.pn * tsB;
    S.a_ready(cur);
    PG8_STAGE(PG8_SB(0, 0), cB, voffB); PG8_STAGE(PG8_SB(0, 1), cB + hsB, voffB); PG8_STAGE(PG8_SA(0, 0), cA, voffA); PG8_STAGE(PG8_SA(0, 1), cA + hsA, voffA);
    if (wr == 1) PG8_BAR;
    PG8_WAIT_V(2); PG8_BAR;
    PG8_STAGE(PG8_SB(1, 0), cB + kstep, voffB); PG8_STAGE(PG8_SA(1, 0), cA + kstep, voffA); PG8_STAGE(PG8_SB(1, 1), cB + hsB + kstep, voffB);
    PG8_WAIT_V(6); PG8_BAR;
    for (;;) {
        const bool has_next = S.next(ui + 1, nxt);
        const char* nA = has_next ? (const char*)g.A + (size_t)nxt.pm * tsA : cA; const char* nB = has_next ? (const char*)g.Bt + (size_t)nxt.pn * tsB : cB;
#define PG8_TRIP(W1, W2) do { \
            const bool last = (t == nt - 2); \
            const char* a1 = cA + (size_t)(t + 1) * kstep; \
            const char* a2 = last ? nA : cA + (size_t)(t + 2) * kstep; const char* b2 = last ? nB : cB + (size_t)(t + 2) * kstep; \
            const char* a3 = a2 + kstep; const char* b3 = b2 + kstep; \
            if (last && has_next) S.a_ready(nxt); \
            PG8_LDB(B0, 0, 0); PG8_LDB(B1, 0, 1); PG8_SCHED; PG8_LDA(At, 0, 0); PG8_STAGE(PG8_SA(1, 1), a1 + hsA, voffA); \
            W1; PG8_WAIT_L(0); PG8_BAR; PG8_MMA(0, 0, At, B0); PG8_MMA(0, 1, At, B1); PG8_BAR; PG8_SCHED; \
            PG8_LDA(At, 0, 1); PG8_STAGE(PG8_SB(0, 0), b2, voffB); PG8_STAGE(PG8_SB(0, 1), b2 + hsB, voffB); PG8_STAGE(PG8_SA(0, 0), a2, voffA); \
            W2; PG8_WAIT_L(0); PG8_BAR; PG8_MMA(1, 0, At, B0); PG8_MMA(1, 1, At, B1); PG8_BAR; PG8_SCHED; \
            PG8_LDB(B0, 1, 0); PG8_LDB(B1, 1, 1); PG8_SCHED; PG8_LDA(At, 1, 0); PG8_STAGE(PG8_SA(0, 1), a2 + hsA, voffA); \
            PG8_WAIT_V(8); PG8_WAIT_L(0); PG8_BAR; PG8_MMA(0, 0, At, B0); PG8_MMA(0, 1, At, B1); PG8_BAR; PG8_SCHED; \
            PG8_LDA(At, 1, 1); PG8_STAGE(PG8_SB(1, 0), b3, voffB); PG8_STAGE(PG8_SB(1, 1), b3 + hsB, voffB); PG8_STAGE(PG8_SA(1, 0), a3, voffA); \
            PG8_WAIT_V(8); PG8_WAIT_L(0); PG8_BAR; PG8_MMA(1, 0, At, B0); PG8_MMA(1, 1, At, B1); PG8_BAR; PG8_SCHED; } while (0)
#define PG8_WAIT_VN(N) asm volatile("s_waitcnt vmcnt(%0)" :: "n"(N) : "memory")
        int t = 0;
        if (ui > 0) { PG8_TRIP(PG8_WAIT_VN(8 + Epi::NVM), PG8_WAIT_VN(8 + Epi::NVM)); t = 2; }
#pragma unroll 1
        for (; t < nt; t += 2) PG8_TRIP(PG8_WAIT_V(8), PG8_WAIT_V(8));
#undef PG8_TRIP
#undef PG8_WAIT_VN
        if (wr == 0) PG8_BAR;
        E(acc, cur, wr, wc, fr, fq); S.done(cur);
        if (!has_next) break;
#pragma unroll
        for (int a = 0; a < 2; ++a)
#pragma unroll
            for (int b = 0; b < 2; ++b)
#pragma unroll
                for (int m = 0; m < 4; ++m)
#pragma unroll
                    for (int n = 0; n < 2; ++n) acc[a][b][m][n] = (f32x4){0.f, 0.f, 0.f, 0.f};
        cur = nxt; cA = nA; cB = nB; ++ui;
        if (wr == 1) PG8_BAR;
    }
    PG8_WAIT_V(0);
    PG8_BAR;
#undef PG8_SA
#undef PG8_SB
#undef PG8_STAGE
#undef PG8_LDA
#undef PG8_LDB
#undef PG8_MMA
#undef PG8_LO
#undef PG8_HI
#undef PG8_RDA
#undef PG8_RDB
#undef PG8_WAIT_V
#undef PG8_WAIT_L
#undef PG8_BAR
#undef PG8_SCHED
}
}

#define XB_TMO      128
#define XB_XCNT(j)  (256  + 64 * (j))
#define XB_XSUB(j)  (1280 + 64 * (j))
#define XB_XGEN(j)  (2304 + 64 * (j))
#define XB_TOP      3328
#define XB_TOPGEN   3392
#define XCD_BAR_WORDS 3456
#define XB_SPIN_CAP (1u << 20)
__device__ __forceinline__ unsigned xb_ld(unsigned* p)              { return __hip_atomic_load(p, __ATOMIC_RELAXED, __HIP_MEMORY_SCOPE_AGENT); }
__device__ __forceinline__ unsigned xb_add(unsigned* p, unsigned v) { return __hip_atomic_fetch_add(p, v, __ATOMIC_RELAXED, __HIP_MEMORY_SCOPE_AGENT); }
__device__ __forceinline__ unsigned xb_xcc_id() { return (unsigned)__builtin_amdgcn_s_getreg((3 << 11) | 20) & 0xFu; }
#define XB_SPIN(cond, bar) do { unsigned _sp = 0; while (cond) { __builtin_amdgcn_s_sleep(1); \
    if ((++_sp & 255u) == 0u) { if (xb_ld(&(bar)[XB_TMO])) break; if (_sp > XB_SPIN_CAP) { atomicAdd(&(bar)[XB_TMO], 1u); break; } } } } while (0)
struct XcdBarrier { unsigned* bar; unsigned x; volatile LAS unsigned* st; };
__device__ __forceinline__ XcdBarrier xcd_barrier_post(unsigned* bar, volatile LAS unsigned* st, bool t0) {
    XcdBarrier b; b.bar = bar; b.x = xb_xcc_id(); b.st = st;
    if (t0) (void)xb_add(&bar[XB_XCNT(b.x)], 1u);
    return b;
}
__device__ __forceinline__ void xcd_barrier_complete(unsigned* bar, unsigned x, unsigned& nloc, unsigned& nx) {
    const unsigned G = gridDim.x * gridDim.y * gridDim.z;
    unsigned sum, cnt, mine, sp = 0u;
    for (;;) {
        sum = 0u; cnt = 0u; mine = 0u;
#pragma unroll
        for (unsigned j = 0; j < 16; ++j) { const unsigned c = xb_ld(&bar[XB_XCNT(j)]); sum += c; cnt += (c > 0u) ? 1u : 0u; mine = (j == x) ? c : mine; }
        if (sum == G) break;
        __builtin_amdgcn_s_sleep(1);
        if ((++sp & 255u) == 0u) { if (xb_ld(&bar[XB_TMO])) break; if (sp > XB_SPIN_CAP) { atomicAdd(&bar[XB_TMO], 1u); break; } }
    }
    nloc = mine > 0u ? mine : 1u; nx = cnt > 0u ? cnt : 1u;
}
__device__ __forceinline__ void xcd_barrier(const XcdBarrier& b, bool t0) {
    asm volatile("s_waitcnt vmcnt(0)" ::: "memory");
    __syncthreads();
    if (t0) {
        unsigned* bar = b.bar;
        __builtin_amdgcn_s_waitcnt(0);
        unsigned nloc = b.st[0], nx = b.st[1];
        if (nloc == 0u) { xcd_barrier_complete(bar, b.x, nloc, nx); b.st[0] = nloc; b.st[1] = nx; }
        const unsigned old = xb_add(&bar[XB_XSUB(b.x)], 1u);
        const unsigned gen = old / nloc;
        if (old + 1u == (gen + 1u) * nloc) {
            __builtin_amdgcn_fence(__ATOMIC_RELEASE, "agent");
            asm volatile("s_waitcnt vmcnt(0)" ::: "memory");
            const unsigned og = xb_add(&bar[XB_TOP], 1u);
            const unsigned tg = og / nx;
            if (og + 1u == (tg + 1u) * nx) xb_add(&bar[XB_TOPGEN], 1u);
            else XB_SPIN(xb_ld(&bar[XB_TOPGEN]) == tg, bar);
            __builtin_amdgcn_fence(__ATOMIC_ACQUIRE, "agent");
            xb_add(&bar[XB_XGEN(b.x)], 1u);
            asm volatile("s_waitcnt vmcnt(0)" ::: "memory");
        } else {
            XB_SPIN(xb_ld(&bar[XB_XGEN(b.x)]) == gen, bar);
            __builtin_amdgcn_fence(__ATOMIC_ACQUIRE, "agent");
            asm volatile("s_waitcnt vmcnt(0)" ::: "memory");
        }
    }
    __syncthreads();
}

struct Args {
    const float* in[30];
    float* out; unsigned char* ws;
    int ph_lo, ph_hi;
};
typedef const __attribute__((address_space(4))) Args* KA;
enum { I_X = 0, I_MIXNORM_E, I_WIN, I_GMNORM, I_GMWS, I_GMBS, I_LQ1, I_LK1, I_LQ2, I_LK2, I_SUBLN, I_WOUT, I_FFNNORM, I_FFNGU, I_FFNDN,
       I_MIXNORM_O, I_LAMRE, I_LAMIM, I_LOGDT, I_BRE, I_BIM, I_CRE, I_CIM, I_S5D, I_GLUW, I_MOENORM, I_ROUTER, I_EGU, I_EDN, I_FINALNORM };

__device__ __forceinline__ float row_load_rstd(const float* xrow, int lane, f32x4 (&v)[8]) {
    const f32x4* xr = (const f32x4*)xrow + lane; float s = 0.f;
#pragma unroll
    for (int j = 0; j < 8; ++j) { v[j] = xr[64 * j]; s += (v[j].x * v[j].x + v[j].y * v[j].y) + (v[j].z * v[j].z + v[j].w * v[j].w); }
    return rsqrtf(wave_sum(s) * (1.f / DM) + EPS);
}
__device__ __forceinline__ void rmsnorm_rows_bf16(const float* X, const float* gain, bf16_t* O, int gw, int NGW, int lane) {
    f32x4 gv[8];
#pragma unroll
    for (int j = 0; j < 8; ++j) gv[j] = ((const f32x4*)gain)[lane + 64 * j];
    for (int m = gw; m < M; m += NGW) {
        f32x4 v[8]; const float rstd = row_load_rstd(X + (size_t)m * DM, lane, v);
        u32x2* o = (u32x2*)(O + (size_t)m * DM) + lane;
#pragma unroll
        for (int j = 0; j < 8; ++j) { u32x2 w; w.x = pk2(v[j].x * rstd * gv[j].x, v[j].y * rstd * gv[j].y); w.y = pk2(v[j].z * rstd * gv[j].z, v[j].w * rstd * gv[j].w); o[64 * j] = w; }
    }
}

__device__ __forceinline__ void p0_transpose_item(const float* W, int K, int N, bf16_t* WT, int F  , LAS float* scr, int item, int lane, const float* gain = nullptr  ) {
    const int nblk = N / 32, kb = item / nblk, nb = item % nblk, k0 = 64 * kb, n0 = 32 * nb;
    int d0 = n0;
    if (F) { const int j = (n0 < F) ? n0 : n0 - F; d0 = (j >> 7) * 256 + (j & 127) + ((n0 < F) ? 0 : 128); }
    const int c = lane & 7;
    f32x4 ga = (f32x4){1.f, 1.f, 1.f, 1.f}, gb = ga;
    if (gain) { ga = *(const f32x4*)(gain + k0 + 8 * c); gb = *(const f32x4*)(gain + k0 + 8 * c + 4); }
    { float tv[32]; const float* wp = W + (size_t)(k0 + (lane >> 5)) * N + n0 + (lane & 31);
#pragma unroll
      for (int i = 0; i < 32; ++i) tv[i] = __builtin_nontemporal_load(wp + (size_t)(2 * i) * N);
#pragma unroll
      for (int i = 0; i < 32; ++i) scr[(2 * i + (lane >> 5)) * 33 + (lane & 31)] = tv[i]; }
    asm volatile("s_waitcnt lgkmcnt(0)" ::: "memory");
#pragma unroll
    for (int j = 0; j < 4; ++j) { const int n = (lane >> 3) + 8 * j; const LAS float* s = scr + (8 * c) * 33 + n;
        u32x4 o; o.x = pk2(s[0 * 33] * ga[0], s[1 * 33] * ga[1]); o.y = pk2(s[2 * 33] * ga[2], s[3 * 33] * ga[3]); o.z = pk2(s[4 * 33] * gb[0], s[5 * 33] * gb[1]); o.w = pk2(s[6 * 33] * gb[2], s[7 * 33] * gb[3]);
        __builtin_nontemporal_store(o, (u32x4*)(WT + (size_t)(d0 + n) * K + k0 + 8 * c)); }
    asm volatile("s_waitcnt lgkmcnt(0)" ::: "memory");
}

__device__ __forceinline__ void p0_transpose_item8(const float* W, int K, int N, unsigned char* WT, int F, float scale, LAS float* scr, int item, int lane) {
    const int nblk = N / 32, kb = item / nblk, nb = item % nblk, k0 = 128 * kb, n0 = 32 * nb;
    int d0 = n0;
    if (F) { const int j = (n0 < F) ? n0 : n0 - F; d0 = (j >> 7) * 256 + (j & 127) + ((n0 < F) ? 0 : 128); }
    { float tv[64]; const float* wp = W + (size_t)(k0 + (lane >> 5)) * N + n0 + (lane & 31);
#pragma unroll
      for (int i = 0; i < 64; ++i) tv[i] = __builtin_nontemporal_load(wp + (size_t)(2 * i) * N);
#pragma unroll
      for (int i = 0; i < 64; ++i) scr[(2 * i + (lane >> 5)) * 33 + (lane & 31)] = tv[i]; }
    asm volatile("s_waitcnt lgkmcnt(0)" ::: "memory");
    const int c = lane & 7;
#pragma unroll
    for (int j = 0; j < 4; ++j) { const int n = (lane >> 3) + 8 * j; const LAS float* sp = scr + (16 * c) * 33 + n;
        u32x4 o;
        o.x = pk4_fp8(sp[0 * 33] * scale, sp[1 * 33] * scale, sp[2 * 33] * scale, sp[3 * 33] * scale); o.y = pk4_fp8(sp[4 * 33] * scale, sp[5 * 33] * scale, sp[6 * 33] * scale, sp[7 * 33] * scale);
        o.z = pk4_fp8(sp[8 * 33] * scale, sp[9 * 33] * scale, sp[10 * 33] * scale, sp[11 * 33] * scale); o.w = pk4_fp8(sp[12 * 33] * scale, sp[13 * 33] * scale, sp[14 * 33] * scale, sp[15 * 33] * scale);
        __builtin_nontemporal_store(o, (u32x4*)(WT + (size_t)(d0 + n) * K + k0 + 16 * c)); }
    asm volatile("s_waitcnt lgkmcnt(0)" ::: "memory");
}

__device__ __forceinline__ void p0_transpose_item6(const float* W, int K, int N, unsigned char* WT, int F, LAS float* scr, int item, int lane) {
    const int nblk = N / 32, kb = item / nblk, nb = item % nblk, k0 = 128 * kb, n0 = 32 * nb;
    int d0 = n0;
    if (F) { const int j = (n0 < F) ? n0 : n0 - F; d0 = (j >> 7) * 256 + (j & 127) + ((n0 < F) ? 0 : 128); }
    { float tv[64]; const float* wp = W + (size_t)(k0 + (lane >> 5)) * N + n0 + (lane & 31);
#pragma unroll
      for (int i = 0; i < 64; ++i) tv[i] = __builtin_nontemporal_load(wp + (size_t)(2 * i) * N);
#pragma unroll
      for (int i = 0; i < 64; ++i) scr[(2 * i + (lane >> 5)) * 33 + (lane & 31)] = tv[i]; }
    asm volatile("s_waitcnt lgkmcnt(0)" ::: "memory");
    const int c = lane & 3;
#pragma unroll
    for (int j = 0; j < 2; ++j) { const int n = (lane >> 2) + 16 * j; const LAS float* sp = scr + (32 * c) * 33 + n;
        float x[32];
#pragma unroll
        for (int q = 0; q < 32; ++q) x[q] = sp[q * 33];
        u32x6 pk; unsigned sb; quant_fp6_block(x, pk, sb);
        unsigned char* dst = WT + (size_t)(d0 + n) * K + k0 + 16 * c;
        __builtin_nontemporal_store((u32x4){pk[0], pk[1], pk[2], pk[3]}, (u32x4*)dst); __builtin_nontemporal_store((u32x4){pk[4], pk[5], sb, 0u}, (u32x4*)(dst + 64)); }
    asm volatile("s_waitcnt lgkmcnt(0)" ::: "memory");
}

__device__ __forceinline__ void s5_prep_unit(KA a, LAS unsigned char* lds, int g, int nh, int tid) {
    constexpr int PS = 65, KS = 260;
    LAS float* PW = (LAS float*)lds;
    LAS float* BB = PW + 2 * 33 * PS * 2;
    LAS float* CM = BB + 2 * 64 * 16 * 2;
    LAS float* KD = CM + 2 * 16 * PS * 2;
    const float* lam_re = a->in[I_LAMRE]; const float* lam_im = a->in[I_LAMIM]; const float* log_dt = a->in[I_LOGDT];
    const float* b_re = a->in[I_BRE]; const float* b_im = a->in[I_BIM]; const float* c_re = a->in[I_CRE]; const float* c_im = a->in[I_CIM]; const float* dsk = a->in[I_S5D];
    if (tid < 128) {
        const int d = tid >> 6, p = tid & 63;
        const float dt = expf(log_dt[d * S5G + g]);
        const float lr = lam_re[(d * S5G + g) * 64 + p], li = lam_im[(d * S5G + g) * 64 + p];
        const float ar = lr * dt, ai = li * dt;
        for (int j = 0; j <= 32; ++j) {
            const float mag = expf((float)j * ar);
            const double rev = (double)j * (double)ai * 0.15915494309189535; const float fr = (float)(rev - rint(rev));
            PW[((d * 33 + j) * PS + p) * 2 + 0] = mag * __builtin_amdgcn_cosf(fr); PW[((d * 33 + j) * PS + p) * 2 + 1] = mag * __builtin_amdgcn_sinf(fr);
        }
        asm volatile("s_waitcnt lgkmcnt(0)" ::: "memory");
        const float xr = PW[((d * 33 + 1) * PS + p) * 2 + 0] - 1.f, xi = PW[((d * 33 + 1) * PS + p) * 2 + 1];
        const float den = 1.f / (lr * lr + li * li), cr = (xr * lr + xi * li) * den, ci = (xi * lr - xr * li) * den;
        for (int c = 0; c < 16; ++c) { const float br = b_re[((size_t)(d * S5G + g) * 64 + p) * 16 + c], bi = b_im[((size_t)(d * S5G + g) * 64 + p) * 16 + c];
            BB[((d * 64 + p) * 16 + c) * 2 + 0] = cr * br - ci * bi; BB[((d * 64 + p) * 16 + c) * 2 + 1] = cr * bi + ci * br; }
        for (int c = 0; c < 16; ++c) { CM[((d * 16 + c) * PS + p) * 2 + 0] = c_re[((size_t)(d * S5G + g) * 16 + c) * 64 + p]; CM[((d * 16 + c) * PS + p) * 2 + 1] = c_im[((size_t)(d * S5G + g) * 16 + c) * 64 + p]; }
    }
    __syncthreads();
    for (int q = tid; q < 1024; q += 512) {
        const int d = q >> 9, j = (q >> 4) & 31, co = q & 15; float acc[16];
#pragma unroll
        for (int c = 0; c < 16; ++c) acc[c] = 0.f;
        for (int p = 0; p < 64; ++p) {
            const float cr = CM[((d * 16 + co) * PS + p) * 2], ci = CM[((d * 16 + co) * PS + p) * 2 + 1], pr = PW[((d * 33 + j) * PS + p) * 2], pi = PW[((d * 33 + j) * PS + p) * 2 + 1];
            const float wr = cr * pr - ci * pi, wi = cr * pi + ci * pr;
            const LAS float* bb = BB + (d * 64 + p) * 32;
#pragma unroll
            for (int c = 0; c < 16; ++c) acc[c] += wr * bb[2 * c] - wi * bb[2 * c + 1];
        }
#pragma unroll
        for (int c = 0; c < 16; ++c) KD[(d * 32 + j) * KS + co * 16 + c] = acc[c];
    }
    __syncthreads();
    bf16_t* BY = (bf16_t*)(a->ws + WS_S5BY) + (size_t)g * 512 * S5K; bf16_t* BZ = (bf16_t*)(a->ws + WS_S5BZ) + (size_t)g * 256 * 512;
    for (int id = tid; id < 256 * 64; id += 512) {
        const int nl = id >> 6, kc = id & 63, n = 256 * nh + nl, t = n >> 4, co = n & 15, s = kc >> 1, c0 = (kc & 1) * 8; float v[8];
#pragma unroll
        for (int c = 0; c < 8; ++c) { float x = 0.f;
            if (t >= s) x += KD[(0 * 32 + (t - s)) * KS + co * 16 + c0 + c];
            if (s >= t) x += KD[(1 * 32 + (s - t)) * KS + co * 16 + c0 + c];
            if (t == s && c0 + c == co) x += dsk[g * 16 + co];
            v[c] = x; }
        u32x4 w; w.x = pk2(v[0], v[1]); w.y = pk2(v[2], v[3]); w.z = pk2(v[4], v[5]); w.w = pk2(v[6], v[7]);
        *(u32x4*)(BY + (size_t)n * S5K + kc * 8) = w;
    }
    for (int id = tid; id < 256 * 32; id += 512) {
        const int nl = id >> 5, kc = id & 31, n = 256 * nh + nl, t = n >> 4, co = n & 15, d = kc >> 4, p0 = (kc & 15) * 4, e = d ? (32 - t) : (t + 1); float v[8];
#pragma unroll
        for (int q = 0; q < 4; ++q) { const int p = p0 + q; const float cr = CM[((d * 16 + co) * PS + p) * 2], ci = CM[((d * 16 + co) * PS + p) * 2 + 1], pr = PW[((d * 33 + e) * PS + p) * 2], pi = PW[((d * 33 + e) * PS + p) * 2 + 1];
            v[2 * q] = cr * pr - ci * pi; v[2 * q + 1] = -(cr * pi + ci * pr); }
        u32x4 w; w.x = pk2(v[0], v[1]); w.y = pk2(v[2], v[3]); w.z = pk2(v[4], v[5]); w.w = pk2(v[6], v[7]);
        *(u32x4*)(BY + (size_t)n * S5K + 512 + kc * 8) = w;
    }
    for (int id = tid; id < 128 * 64; id += 512) {
        const int nl = id >> 6, kc = id & 63, d = nh, p = nl >> 1, ri = nl & 1, s = kc >> 1, c0 = (kc & 1) * 8, e = d ? s : (31 - s); float v[8];
        const float pr = PW[((d * 33 + e) * PS + p) * 2], pi = PW[((d * 33 + e) * PS + p) * 2 + 1];
#pragma unroll
        for (int c = 0; c < 8; ++c) { const float br = BB[((d * 64 + p) * 16 + c0 + c) * 2], bi = BB[((d * 64 + p) * 16 + c0 + c) * 2 + 1]; v[c] = ri ? (pr * bi + pi * br) : (pr * br - pi * bi); }
        u32x4 w; w.x = pk2(v[0], v[1]); w.y = pk2(v[2], v[3]); w.z = pk2(v[4], v[5]); w.w = pk2(v[6], v[7]);
        *(u32x4*)(BZ + (size_t)(128 * nh + nl) * 512 + kc * 8) = w;
    }
    __syncthreads();
}

__device__ __forceinline__ void gating_phase(KA a, LAS unsigned char* lds, int u0, int ustride, int tid) {
    int lane = tid & 63; asm volatile("" : "+v"(lane)); const int wid = tid >> 6;
    const bf16_t* PROJ = (const bf16_t*)(a->ws + WS_PROJ); bf16_t* MIXED = (bf16_t*)(a->ws + WS_MIXED);
    LAS bf16_t* VT = (LAS bf16_t*)lds;
    LAS bf16_t* OT = (LAS bf16_t*)(lds + 69632);
    const int fr = lane & 15, fq = lane >> 4;
    u32x2 rawv[16];
#define GT_TOK0(u_) ((size_t)((u_) >> 6) * SEQ + (((u_) >> 2) & 15) * 128)
#define GT_LDV(u_) do { const size_t t0_ = GT_TOK0(u_); const int g_ = (u_) & 3; _Pragma("unroll") for (int i = 0; i < 16; ++i) rawv[i] = *(const u32x2*)(PROJ + (t0_ + wid * 16 + i) * MIX_IN + 1024 + g_ * 256 + 4 * lane); } while (0)
    if (u0 < 1024) GT_LDV(u0);
    for (int u = u0; u < 1024; u += ustride) {
        const int g = u & 3; const size_t tok0 = GT_TOK0(u);
        const bf16_t* WSB = (const bf16_t*)(a->ws + WS_GMWS) + g * 128 * 128; const float* gmn = a->in[I_GMNORM] + g * 256; const float* gbs = a->in[I_GMBS] + g * 128;
        { const f32x4 gn = *(const f32x4*)(gmn + 4 * lane);
#pragma unroll
          for (int i = 0; i < 16; ++i) { const int s = wid * 16 + i;
            const u32x2 raw = rawv[i];
            const float v0 = bflo(raw.x), v1 = bfhi(raw.x), v2 = bflo(raw.y), v3 = bfhi(raw.y);
            const float rstd = rsqrtf(wave_sum((v0 * v0 + v1 * v1) + (v2 * v2 + v3 * v3)) * (1.f / 256.f) + EPS);
            const unsigned w0 = pk2(v0 * rstd * gn.x, v1 * rstd * gn.y), w1 = pk2(v2 * rstd * gn.z, v3 * rstd * gn.w);
            VT[(4 * lane + 0) * 136 + s] = (bf16_t)(w0 & 0xffff); VT[(4 * lane + 1) * 136 + s] = (bf16_t)(w0 >> 16);
            VT[(4 * lane + 2) * 136 + s] = (bf16_t)(w1 & 0xffff); VT[(4 * lane + 3) * 136 + s] = (bf16_t)(w1 >> 16); } }
        __syncthreads();
        if (u + ustride < 1024) GT_LDV(u + ustride);
        u32x4 uv[8];
#pragma unroll
        for (int j = 0; j < 8; ++j) { const int idx = tid + 512 * j, t = idx >> 5, ch = idx & 31; uv[j] = *(const u32x4*)(PROJ + (tok0 + t) * MIX_IN + g * 256 + ch * 8); }
        f32x4 acc[2][8];
#pragma unroll
        for (int cb = 0; cb < 2; ++cb)
#pragma unroll
            for (int tb = 0; tb < 8; ++tb) acc[cb][tb] = (f32x4){0.f, 0.f, 0.f, 0.f};
#pragma unroll 2
        for (int ks = 0; ks < 4; ++ks) {
            bf16x8 af[2];
#pragma unroll
            for (int cb = 0; cb < 2; ++cb) af[cb] = *(const LAS bf16x8*)(VT + (32 * wid + 16 * cb + fr) * 136 + 32 * ks + 8 * fq);
#pragma unroll
            for (int tb = 0; tb < 8; ++tb) { const bf16x8 bfm = *(const bf16x8*)(WSB + (16 * tb + fr) * 128 + 32 * ks + 8 * fq);
#pragma unroll
                for (int cb = 0; cb < 2; ++cb) acc[cb][tb] = __builtin_amdgcn_mfma_f32_16x16x32_bf16(af[cb], bfm, acc[cb][tb], 0, 0, 0); }
        }
#pragma unroll
        for (int tb = 0; tb < 8; ++tb) { const int t = 16 * tb + fr; const float bs = gbs[t];
#pragma unroll
            for (int cb = 0; cb < 2; ++cb) { const int c = 32 * wid + 16 * cb + 4 * fq; const f32x4 mx = acc[cb][tb];
                u32x2 w; w.x = pk2(mx[0] + bs, mx[1] + bs); w.y = pk2(mx[2] + bs, mx[3] + bs);
                *(LAS u32x2*)(OT + t * 264 + c) = w; } }
        __syncthreads();
#pragma unroll
        for (int j = 0; j < 8; ++j) { const int idx = tid + 512 * j, t = idx >> 5, ch = idx & 31; const u32x4 mv = *(const LAS u32x4*)(OT + t * 264 + ch * 8); const u32x4 u4 = uv[j]; u32x4 w;
            w.x = pk2(bflo(u4.x) * bflo(mv.x), bfhi(u4.x) * bfhi(mv.x)); w.y = pk2(bflo(u4.y) * bflo(mv.y), bfhi(u4.y) * bfhi(mv.y));
            w.z = pk2(bflo(u4.z) * bflo(mv.z), bfhi(u4.z) * bfhi(mv.z)); w.w = pk2(bflo(u4.w) * bflo(mv.w), bfhi(u4.w) * bfhi(mv.w));
            *(u32x4*)(MIXED + (tok0 + t) * DM + g * 256 + ch * 8) = w; }
        __syncthreads();
    }
#undef GT_LDV
#undef GT_TOK0
}

constexpr int AT_KB = 9216, AT_VB = 20480, AT_K0 = 0, AT_V0 = 2 * AT_KB, AT_SCR = AT_V0 + 2 * AT_VB  , AT_SSQ = AT_SCR + 8 * 256  , AT_Q = AT_SSQ + 8 * 4224  ;
__device__ __forceinline__ int crow(int r, int hi) { return (r & 3) + 8 * (r >> 2) + 4 * hi; }
__device__ __forceinline__ void attn_unit(KA a, LAS unsigned char* lds, int b, int h, int qb, float lam, int tid_in) {
    int tid = tid_in; asm volatile("" : "+v"(tid));
    int lane = tid & 63; asm volatile("" : "+v"(lane));
    const int wid = __builtin_amdgcn_readfirstlane(tid >> 6), r32 = lane & 31, hi = lane >> 5;
    const bf16_t* PROJ = (const bf16_t*)(a->ws + WS_PROJ); bf16_t* MIXED = (bf16_t*)(a->ws + WS_MIXED); float* O0S = (float*)(a->ws + WS_O0);
    const size_t tokb = (size_t)b * SEQ; const int q0 = qb * 256 + wid * 32;
    const float sl2 = exp2f(-(float)(h + 1)) * 1.4426950408889634f;
    LAS float* scr = (LAS float*)(lds + AT_SCR) + wid * 64;
    LAS float* ssq = (LAS float*)(lds + AT_SSQ) + wid * 1056;
    const int krow = tid >> 3, kch = tid & 7;
    const int vrow0 = tid >> 4, vch = tid & 15;
    const int tr_q = (lane & 15) >> 2, tr_p = lane & 3, tr_blk = (lane >> 4) & 1;
    const int vrd = (4 * hi + tr_q) * 320 + (16 * tr_blk + 4 * tr_p) * 2;
    const int t0 = 4 * qb;
    for (int mp = 0; mp < 2; ++mp) {
        const bf16_t* Kg = PROJ + tokb * MIX_IN + 3072 + h * 128 + mp * 64;
        const bf16_t* Vg = PROJ + tokb * MIX_IN + 4096 + h * 128;
        LAS unsigned char* QB = lds + AT_Q + wid * 4608 + r32 * 144 + hi * 16;
#pragma unroll
        for (int d0 = 0; d0 < 4; ++d0) *(LAS bf16x8*)(QB + d0 * 32) = *(const bf16x8*)(PROJ + (tokb + q0 + r32) * MIX_IN + 2048 + h * 128 + mp * 64 + d0 * 16 + hi * 8);
        f32x16 o[4];
#pragma unroll
        for (int e = 0; e < 4; ++e)
#pragma unroll
            for (int r = 0; r < 16; ++r) o[e][r] = 0.f;
        float mref = -1e30f, lsum = 0.f;
        u32x4 kreg, vreg0, vreg1;
#define AT_LDK(i_) (*(const u32x4*)(Kg + (size_t)((((t0 + (i_)) & 31) * 64) + krow) * MIX_IN + kch * 8))
#define AT_LDV(i_, ro) (*(const u32x4*)(Vg + (size_t)((((t0 + (i_)) & 31) * 64) + vrow0 + (ro)) * MIX_IN + vch * 8))
#define AT_STK(buf, v) (*(LAS u32x4*)(lds + AT_K0 + (buf) * AT_KB + krow * 144 + kch * 16) = (v))
#define AT_STV(buf, ro, v) (*(LAS u32x4*)(lds + AT_V0 + (buf) * AT_VB + (vrow0 + (ro)) * 320 + vch * 16) = (v))
#define AT_QK(D0, D1, buf) do { const LAS unsigned char* KB_ = lds + AT_K0 + (buf) * AT_KB; \
            _Pragma("unroll") for (int r_ = 0; r_ < 16; ++r_) { D0[r_] = 0.f; D1[r_] = 0.f; } \
            _Pragma("unroll") for (int d0 = 0; d0 < 4; ++d0) { \
                const bf16x8 ka = *(const LAS bf16x8*)(KB_ + r32 * 144 + d0 * 32 + hi * 16), kb = *(const LAS bf16x8*)(KB_ + (32 + r32) * 144 + d0 * 32 + hi * 16); \
                const bf16x8 qf = *(const LAS bf16x8*)(QB + d0 * 32); \
                D0 = __builtin_amdgcn_mfma_f32_32x32x16_bf16(ka, qf, D0, 0, 0, 0); D1 = __builtin_amdgcn_mfma_f32_32x32x16_bf16(kb, qf, D1, 0, 0, 0); } } while (0)
        { kreg = AT_LDK(0); vreg0 = AT_LDV(0, 0); vreg1 = AT_LDV(0, 32); const u32x4 k1 = AT_LDK(1);
          AT_STK(0, kreg); AT_STV(0, 0, vreg0); AT_STV(0, 32, vreg1); AT_STK(1, k1); }
        __syncthreads();
        f32x16 p0, p1;
        AT_QK(p0, p1, 0);
        __syncthreads();
#define AT_STEP(HAS1, HAS2) do { \
            const int k0 = ((t0 + it) & 31) * 64; \
            if (HAS2) kreg = AT_LDK(it + 2); \
            if (HAS1) { vreg0 = AT_LDV(it + 1, 0); vreg1 = AT_LDV(it + 1, 32); } \
            f32x16 n0, n1; \
            if (HAS1) AT_QK(n0, n1, (it + 1) & 1); \
            __builtin_amdgcn_sched_barrier(0); \
            const LAS unsigned char* VB = lds + AT_V0 + (it & 1) * AT_VB; \
            float xf = (float)(q0 + r32 - k0 - 4 * hi); asm volatile("" : "+v"(xf));   \
            float rm = -1e30f; \
            _Pragma("unroll") for (int r = 0; r < 16; ++r) { const float dd = xf - (float)((r & 3) + 8 * (r >> 2)); \
                p0[r] = p0[r] - sl2 * fabsf(dd); p1[r] = p1[r] - sl2 * fabsf(dd - 32.f); rm = fmaxf(rm, fmaxf(p0[r], p1[r])); } \
            rm = half_max(rm); \
            if (__any(rm > mref + 8.f)) { \
                const float mn = fmaxf(mref, rm), al = __builtin_amdgcn_exp2f(mref - mn); mref = mn; lsum *= al; \
                if (hi == 0) scr[r32] = al; \
                asm volatile("s_waitcnt lgkmcnt(0)" ::: "memory"); \
                _Pragma("unroll") for (int r = 0; r < 16; ++r) { const float f = scr[crow(r, hi)]; \
                    _Pragma("unroll") for (int e = 0; e < 4; ++e) o[e][r] *= f; } \
            } \
            float ps = 0.f; \
            _Pragma("unroll") for (int r = 0; r < 16; ++r) { p0[r] = __builtin_amdgcn_exp2f(p0[r] - mref); p1[r] = __builtin_amdgcn_exp2f(p1[r] - mref); ps += p0[r]; ps += p1[r]; }   \
            lsum += ps; \
            bf16x8 pa[4]; \
            { u32x4 w; \
              w.x = pk2(p0[0], p0[1]); w.y = pk2(p0[2], p0[3]); w.z = pk2(p0[4], p0[5]); w.w = pk2(p0[6], p0[7]); pa[0] = __builtin_bit_cast(bf16x8, w); \
              w.x = pk2(p0[8], p0[9]); w.y = pk2(p0[10], p0[11]); w.z = pk2(p0[12], p0[13]); w.w = pk2(p0[14], p0[15]); pa[1] = __builtin_bit_cast(bf16x8, w); \
              w.x = pk2(p1[0], p1[1]); w.y = pk2(p1[2], p1[3]); w.z = pk2(p1[4], p1[5]); w.w = pk2(p1[6], p1[7]); pa[2] = __builtin_bit_cast(bf16x8, w); \
              w.x = pk2(p1[8], p1[9]); w.y = pk2(p1[10], p1[11]); w.z = pk2(p1[12], p1[13]); w.w = pk2(p1[14], p1[15]); pa[3] = __builtin_bit_cast(bf16x8, w); } \
            __builtin_amdgcn_sched_barrier(0); \
            _Pragma("unroll") for (int ks = 0; ks < 4; ++ks) { \
                _Pragma("unroll") for (int e = 0; e < 4; ++e) { \
                    const LAS unsigned char* vp = VB + vrd + ks * 16 * 320 + e * 64; \
                    const s16x4 lo = __builtin_amdgcn_ds_read_tr16_b64_v4i16((LAS s16x4*)(vp)), hh = __builtin_amdgcn_ds_read_tr16_b64_v4i16((LAS s16x4*)(vp + 8 * 320)); \
                    const bf16x8 vf = (bf16x8){lo[0], lo[1], lo[2], lo[3], hh[0], hh[1], hh[2], hh[3]}; \
                    o[e] = __builtin_amdgcn_mfma_f32_32x32x16_bf16(pa[ks], vf, o[e], 0, 0, 0); } \
                __builtin_amdgcn_sched_barrier(0); } \
            if (HAS2) AT_STK(it & 1, kreg); \
            if (HAS1) { AT_STV((it + 1) & 1, 0, vreg0); AT_STV((it + 1) & 1, 32, vreg1); } \
            __syncthreads(); \
            if (HAS1) { p0 = n0; p1 = n1; } } while (0)
        int it = 0;
        for (; it < 30; ++it) AT_STEP(true, true);
        AT_STEP(true, false); ++it;
        AT_STEP(false, false);
#undef AT_STEP
#undef AT_QK
#undef AT_LDK
#undef AT_LDV
#undef AT_STK
#undef AT_STV
        int r32e = r32, hie = hi; asm volatile("" : "+v"(r32e), "+v"(hie));
        lsum = half_sum(lsum);
        if (hie == 0) scr[r32e] = 1.f / lsum;
        asm volatile("s_waitcnt lgkmcnt(0)" ::: "memory");
#pragma unroll
        for (int r = 0; r < 16; ++r) { const float l_ = scr[crow(r, hie)];
#pragma unroll
            for (int e = 0; e < 4; ++e) o[e][r] *= l_; }
        int tide = tid; asm volatile("" : "+v"(tide));
        u32x4* ob = (u32x4*)O0S + (size_t)((b * 8 + h) * 8 + qb) * (8 * 512) + tide;
        if (mp == 0) {
#pragma unroll
            for (int e = 0; e < 4; ++e) {
#pragma unroll
                for (int h2 = 0; h2 < 2; ++h2) { u32x4 w; w.x = pk2(o[e][8 * h2 + 0], o[e][8 * h2 + 1]); w.y = pk2(o[e][8 * h2 + 2], o[e][8 * h2 + 3]); w.z = pk2(o[e][8 * h2 + 4], o[e][8 * h2 + 5]); w.w = pk2(o[e][8 * h2 + 6], o[e][8 * h2 + 7]);
                    ob[(2 * e + h2) * 512] = w; }
                __builtin_amdgcn_sched_barrier(0); }
        } else {
            float ss[16];
#pragma unroll
            for (int h2 = 0; h2 < 2; ++h2) {
                u32x4 ov[4];
#pragma unroll
                for (int e = 0; e < 4; ++e) ov[e] = ob[(2 * e + h2) * 512];
                __builtin_amdgcn_sched_barrier(0);
#pragma unroll
                for (int rr = 0; rr < 8; ++rr) { float s2 = 0.f;
#pragma unroll
                    for (int e = 0; e < 4; ++e) { const unsigned dw = ov[e][rr >> 1]; const float o0 = (rr & 1) ? bfhi(dw) : bflo(dw);
                        const float d = o0 - lam * o[e][8 * h2 + rr]; o[e][8 * h2 + rr] = d; s2 += d * d; }
                    ss[8 * h2 + rr] = s2; }
                __builtin_amdgcn_sched_barrier(0);
            }
#pragma unroll
            for (int r = 0; r < 16; ++r) ssq[crow(r, hie) * 33 + r32e] = ss[r];
            asm volatile("s_waitcnt lgkmcnt(0)" ::: "memory");
            { float tot = 0.f;
#pragma unroll
              for (int j = 0; j < 32; ++j) tot += ssq[r32e * 33 + j];
              if (hie == 0) scr[r32e] = rsqrtf(tot * (1.f / 128.f) + EPS) * 0.8f; }
            asm volatile("s_waitcnt lgkmcnt(0)" ::: "memory");
            const float* sg = a->in[I_SUBLN];
            float gsub[4];
#pragma unroll
            for (int e = 0; e < 4; ++e) gsub[e] = sg[32 * e + r32e];
            LAS unsigned char* tb = lds + wid * 4096;
            const int lane_e = r32e + 32 * hie;
#pragma unroll
            for (int hf = 0; hf < 2; ++hf) {
#pragma unroll
                for (int r = 0; r < 16; ++r) { const float rs = scr[crow(r, hie)];
#pragma unroll
                    for (int e2 = 0; e2 < 2; ++e2) *(LAS unsigned short*)(tb + crow(r, hie) * 128 + (32 * e2 + r32e) * 2) = (unsigned short)(pk2(o[2 * hf + e2][r] * rs * gsub[2 * hf + e2], 0.f) & 0xffff); }
                asm volatile("s_waitcnt lgkmcnt(0)" ::: "memory");
#pragma unroll
                for (int k = 0; k < 4; ++k) { const int idx = k * 64 + lane_e, row = idx >> 3, ch = idx & 7;
                    const u32x4 v = *(const LAS u32x4*)(tb + row * 128 + ch * 16);
                    *(u32x4*)(MIXED + (tokb + q0 + row) * DM + 1024 + h * 128 + hf * 64 + ch * 8) = v; }
                asm volatile("s_waitcnt lgkmcnt(0)" ::: "memory");
            }
        }
        __syncthreads();
    }
}

constexpr int NPHASE = 17;
__global__ void __launch_bounds__(512, 2) fwd_kernel(Args a_unused) {
    extern __shared__ __attribute__((aligned(16))) unsigned char lds_raw[];
    const KA a0 = (KA)__builtin_amdgcn_kernarg_segment_ptr(); KA a = a0;
    LAS unsigned char* lds = (LAS unsigned char*)lds_raw;
    const int wave = __builtin_amdgcn_readfirstlane((int)threadIdx.x >> 6);
    const int lane = lane_id_v(), tid = wave * 64 + lane;
    const int G = gridDim.x, bx = blockIdx.x;
    const int vcu = (G % 8 == 0) ? (bx % 8) * (G / 8) + bx / 8 : bx;
    const int gw = vcu * 8 + wave, NGW = G * 8;
    unsigned* ctl = (unsigned*)(a->ws + WS_CTL);
    volatile LAS unsigned* MISC = (volatile LAS unsigned*)(lds + LDSCTL_OFF);
    for (int u = tid; u < (LDS_BYTES - LDSCTL_OFF) / 4; u += 512) ((LAS unsigned*)(lds + LDSCTL_OFF))[u] = 0u;
    __syncthreads();
    XcdBarrier bar; bar.bar = ctl + CW_BAR; bar.x = 0; bar.st = nullptr;
    if (!MK_MULTI) bar = xcd_barrier_post(ctl + CW_BAR, MISC + 8, tid == 0);
    const int lo = a->ph_lo, hi = a->ph_hi;
#ifndef PH_MASK
#define PH_MASK 0x1ffff
#endif
#define IN(k) (((PH_MASK >> (k)) & 1) && lo <= (k) && (k) < hi)
#define PH_BEGIN KA a = a0; asm volatile("" : "+s"(a)); const int lane = lane_id_v(), tid = wave * 64 + lane; (void)tid; (void)lane;
#ifndef DUP_MASK
#define DUP_MASK 0
#endif
#define REP(k) for (int rep_ = 0; rep_ < 1 + ((DUP_MASK >> (k)) & 1); ++rep_)
#define SEAM(k) do { if (!MK_MULTI && IN((k) + 1)) xcd_barrier(bar, wave == 0 && lane_id_v() == 0); } while (0)

    bf16_t* HN = (bf16_t*)(a->ws + WS_HN);
    float* H = a->out;

    if (IN(0)) { PH_BEGIN REP(0) {
        for (int u = bx; u < 256; u += G) s5_prep_unit(a, lds, u >> 1, u & 1, tid);
        LAS float* scr = (LAS float*)(lds + wave * 16896);
        constexpr int I0 = 32 * 160, I1 = 32 * 64, I2 = 32 * 352, I3 = 44 * 64, I4 = 16 * 128, I5 = 16 * 448, I6 = 56 * 64;
        constexpr int NITEMS = I0 + I1 + I2 + I3 + I4 + 8 * I5 + 8 * I6;
        for (int it = gw; it < NITEMS; it += NGW) {
            int r = it;
            if (r < I0) { p0_transpose_item(a->in[I_WIN], DM, MIX_IN, (bf16_t*)(a->ws + WS_WIN), 0, scr, r, lane); continue; } r -= I0;
            if (r < I1) { p0_transpose_item(a->in[I_WOUT], DM, DM, (bf16_t*)(a->ws + WS_WOUT), 0, scr, r, lane); continue; } r -= I1;
            if (r < I2) { p0_transpose_item(a->in[I_FFNGU], DM, 2 * DFF, (bf16_t*)(a->ws + WS_WGU), DFF, scr, r, lane, a->in[I_FFNNORM]); continue; } r -= I2;
            if (r < I3) { p0_transpose_item8(a->in[I_FFNDN], DFF, DM, a->ws + WS_WDN, 0, W8_DN_SCALE, scr, r, lane); continue; } r -= I3;
            if (r < I4) { p0_transpose_item8(a->in[I_GLUW], DM, 2 * DM, a->ws + WS_WGLU, DM, W8_GU_SCALE, scr, r, lane); continue; } r -= I4;
            if (r < 8 * I5) { const int e = r / I5; p0_transpose_item6(a->in[I_EGU] + (size_t)e * DM * 2 * DFE, DM, 2 * DFE, a->ws + WS_WEGU + (size_t)e * 2 * DFE * DM, DFE, scr, r % I5, lane); continue; } r -= 8 * I5;
            { const int e = r / I6; p0_transpose_item8(a->in[I_EDN] + (size_t)e * DFE * DM, DFE, DM, a->ws + WS_WEDN + (size_t)e * DM * DFE, 0, W8_DN_SCALE, scr, r % I6, lane); }
        }
        { const float* src = a->in[I_GMWS]; bf16_t* dst = (bf16_t*)(a->ws + WS_GMWS);
          for (int i = bx * 512 + tid; i < 4 * 128 * 128 / 2; i += G * 512) ((unsigned*)dst)[i] = pk2(src[2 * i], src[2 * i + 1]); }
        rmsnorm_rows_bf16(a->in[I_X], a->in[I_MIXNORM_E], HN, gw, NGW, lane);
        }
        SEAM(0);
    }
    if (IN(1)) { PH_BEGIN REP(1) {
        pg8::Gemm g{HN, (const bf16_t*)(a->ws + WS_WIN), DM, DM, DM}; pg8::GridOrder S; S.init(M / 256, MIX_IN / 256, G, bx);
        pg8::EpiProj E{(bf16_t*)(a->ws + WS_PROJ)};
        pg8::gemm_phase(lds, g, S, E, wave);
        }
        SEAM(1);
    }
    if (IN(2)) { PH_BEGIN
        float lam;
        { const float sa = wave_sum(a->in[I_LQ1][lane] * a->in[I_LK1][lane]), sb = wave_sum(a->in[I_LQ2][lane] * a->in[I_LK2][lane]); lam = expf(sa) - expf(sb) + 0.2f; }
        for (int u = vcu; u < 1024; u += G) { const int bh = u >> 3; attn_unit(a, lds, bh >> 3, bh & 7, u & 7, lam, wave * 64 + lane_id_v()); }
    }
    if (IN(2)) { PH_BEGIN
        gating_phase(a, lds, vcu, G, tid);
        SEAM(2);
    }
#if (DUP_MASK >> 2) & 1
    if (IN(2)) { PH_BEGIN
        float lam;
        { const float sa = wave_sum(a->in[I_LQ1][lane] * a->in[I_LK1][lane]), sb = wave_sum(a->in[I_LQ2][lane] * a->in[I_LK2][lane]); lam = expf(sa) - expf(sb) + 0.2f; }
        for (int u = vcu; u < 1024; u += G) { const int bh = u >> 3; attn_unit(a, lds, bh >> 3, bh & 7, u & 7, lam, tid); }
        SEAM(2);
    }
#endif
#if (DUP_MASK >> 17) & 1
    if (IN(2)) { PH_BEGIN
        gating_phase(a, lds, vcu, G, tid);
        SEAM(2);
    }
#endif
    if (IN(3)) { PH_BEGIN REP(3) {
        pg8::Gemm g{(const bf16_t*)(a->ws + WS_MIXED), (const bf16_t*)(a->ws + WS_WOUT), DM, DM, DM}; pg8::GridOrder S; S.init(M / 256, DM / 256, G, bx);
        pg8::EpiResSq E{a->in[I_X], a->ws};
        pg8::gemm_phase(lds, g, S, E, wave);
        }
        SEAM(3);
    }
    if (IN(5)) { PH_BEGIN REP(5) {
        pg8::Gemm g{HN, (const bf16_t*)(a->ws + WS_WGU), DM, DM, DM}; pg8::GridOrder S; S.init(M / 256, 2 * DFF / 256, G, bx);
        int pmA = -1, pmB = -1; bool two_ok = true;
        { pg8::Unit uu; for (int i = 0; S.next(i, uu); ++i) { if (pmA < 0) pmA = uu.pm; else if (uu.pm != pmA) { if (pmB < 0) pmB = uu.pm; else if (uu.pm != pmB) two_ok = false; } } if (pmB < 0) pmB = pmA; }
        LAS float* rst = (LAS float*)(lds + 131072);
        { const int tb_ = tid >> 8, rw_ = tid & 255; const int pm_ = tb_ ? pmB : pmA;
          if (pm_ >= 0) { const f32x4* sp = (const f32x4*)((const float*)(a->ws + WS_SL) + (size_t)(pm_ * 256 + rw_) * 32); float t_ = 0.f;
#pragma unroll
            for (int k = 0; k < 8; ++k) { const f32x4 q4 = sp[k]; t_ += (q4[0] + q4[1]) + (q4[2] + q4[3]); }
            rst[tid] = two_ok ? rsqrtf(t_ * (1.f / DM) + EPS) : __builtin_nanf(""); } }
        __syncthreads();
        pg8::EpiSwiGLUr8<1 << 20> E{a->ws + WS_ACT, DFF, rst, pmA, A8_FFN_SCALE};
        pg8::gemm_phase(lds, g, S, E, wave);
        }
        SEAM(5);
    }
    if (IN(6)) { PH_BEGIN
        pg8::Gemm g{(const bf16_t*)(a->ws + WS_ACT), (const bf16_t*)(a->ws + WS_WDN), DFF / 2, DFF / 2, DFF / 2}; pg8::GridOrder S; S.init(M / 256, DM / 256, G, bx, 1);
#if (DUP_MASK >> 6) & 1
        { pg8::EpiResF32 E2{H, (float*)(a->ws + WS_XP)}; pg8::gemm_phase(lds, g, S, E2, wave); }
#endif
        pg8::EpiResBf E{HN, 1.f / (W8_DN_SCALE * A8_FFN_SCALE)};
        pg8::gemm_phase<1>(lds, g, S, E, wave);
        SEAM(6);
    }
    if (IN(7)) { PH_BEGIN REP(7) {
        bf16_t* UA = (bf16_t*)(a->ws + WS_UA);
        LAS float* gl = (LAS float*)lds;
        for (int i = tid; i < DM / 4; i += 512) ((LAS f32x4*)gl)[i] = ((const f32x4*)a->in[I_MIXNORM_O])[i];
        __syncthreads();
        const int gq = lane >> 3, t = (lane >> 1) & 3, hf = lane & 1;
        for (int m0 = gw * 4; m0 < M; m0 += NGW * 4) {
            const int m = m0 + t;
            const bf16_t* xr = HN + (size_t)m * DM + gq * 16 + hf * 8;
            u32x4 x[16]; float sq_ = 0.f;
#pragma unroll
            for (int j = 0; j < 16; ++j) x[j] = *(const u32x4*)(xr + j * 128);
#pragma unroll
            for (int j = 0; j < 16; ++j) { const u32x4 p = x[j];
                const float a0 = bflo(p.x), a1 = bfhi(p.x), a2 = bflo(p.y), a3 = bfhi(p.y), a4 = bflo(p.z), a5 = bfhi(p.z), a6 = bflo(p.w), a7 = bfhi(p.w);
                sq_ += ((a0 * a0 + a1 * a1) + (a2 * a2 + a3 * a3)) + ((a4 * a4 + a5 * a5) + (a6 * a6 + a7 * a7)); }
            sq_ += swz_xor<1>(sq_); sq_ += swz_xor<8>(sq_); sq_ += swz_xor<16>(sq_); sq_ = half_sum(sq_);
            const float rstd = rsqrtf(sq_ * (1.f / DM) + EPS);
            const int b = m >> 11, sqn = m & 2047, ch = sqn >> 5, sp = sqn & 31;
            bf16_t* up = UA + ((size_t)gq * 1024 + b * 64 + ch) * S5K + sp * 16 + hf * 8;
            unsigned go_ = (unsigned)(gq * 16 + hf * 8) * 4u; asm volatile("" : "+v"(go_));
            const LAS unsigned char* glb = (const LAS unsigned char*)gl + go_;
#pragma unroll
            for (int j = 0; j < 16; ++j) { const u32x4 p = x[j]; const f32x4 g0 = *(const LAS f32x4*)(glb + j * 512), g1 = *(const LAS f32x4*)(glb + j * 512 + 16);
                u32x4 w; w.x = pk2(bflo(p.x) * rstd * g0.x, bfhi(p.x) * rstd * g0.y); w.y = pk2(bflo(p.y) * rstd * g0.z, bfhi(p.y) * rstd * g0.w);
                w.z = pk2(bflo(p.z) * rstd * g1.x, bfhi(p.z) * rstd * g1.y); w.w = pk2(bflo(p.w) * rstd * g1.z, bfhi(p.w) * rstd * g1.w);
                *(u32x4*)(up + (size_t)(8 * j) * 1024 * S5K) = w;
                if ((j & 3) == 3) __builtin_amdgcn_sched_barrier(0); }
        }
        }
        __syncthreads();
        SEAM(7);
    }
    if (IN(8)) { PH_BEGIN REP(8) {
        pg8::Gemm g{(const bf16_t*)(a->ws + WS_UA), (const bf16_t*)(a->ws + WS_S5BZ), S5K, 512, 512}; pg8::BatchOrder<4, 1> S; S.init(S5G, G, bx);
        pg8::EpiZ E{(bf16_t*)(a->ws + WS_Z)};
        pg8::gemm_phase(lds, g, S, E, wave);
        }
        SEAM(8);
    }
    if (IN(9)) { PH_BEGIN REP(9) {
        const bf16_t* Z = (const bf16_t*)(a->ws + WS_Z); bf16_t* UA = (bf16_t*)(a->ws + WS_UA);
        for (int id = bx * 512 + tid; id < S5G * NB * 128; id += G * 512) {
            const int p = id & 63, d = (id >> 6) & 1, b = (id >> 7) & 15, g = id >> 11;
            const float dt = expf(a->in[I_LOGDT][d * S5G + g]);
            const float ar = a->in[I_LAMRE][(d * S5G + g) * 64 + p] * dt, ai = a->in[I_LAMIM][(d * S5G + g) * 64 + p] * dt;
            const float mag = expf(32.f * ar); const double rev = 32.0 * (double)ai * 0.15915494309189535; const float fr = (float)(rev - rint(rev));
            const float lr = mag * __builtin_amdgcn_cosf(fr), li = mag * __builtin_amdgcn_sinf(fr);
            float sr = 0.f, si = 0.f;
            const size_t row0 = (size_t)g * 1024 + b * 64;
            const bf16_t* zp = Z + (row0 + (d ? 63 : 0)) * 256 + d * 128 + 2 * p; bf16_t* up = UA + (row0 + (d ? 63 : 0)) * S5K + 512 + d * 128 + 2 * p;
            const long zstep = d ? -256 : 256, ustep = d ? -(long)S5K : (long)S5K;
#pragma unroll 1
            for (int hb = 0; hb < 4; ++hb) {
                f32x2 zz[16];
#pragma unroll
                for (int i = 0; i < 16; ++i) { const unsigned zw = *(const unsigned*)(zp + (hb * 16 + i) * zstep); zz[i] = (f32x2){bflo(zw), bfhi(zw)}; }
#pragma unroll
                for (int i = 0; i < 16; ++i) {
                    *(unsigned*)(up + (hb * 16 + i) * ustep) = pk2(sr, si);
                    const float nr = lr * sr - li * si + zz[i].x, ni = lr * si + li * sr + zz[i].y; sr = nr; si = ni; }
            }
        }
        }
        SEAM(9);
    }
    if (IN(10)) { PH_BEGIN REP(10) {
        pg8::Gemm g{(const bf16_t*)(a->ws + WS_UA), (const bf16_t*)(a->ws + WS_S5BY), S5K, S5K, S5K}; pg8::BatchOrder<4, 2> S; S.init(S5G, G, bx);
        pg8::EpiS5Y E{a->ws + WS_YG};
        pg8::gemm_phase(lds, g, S, E, wave);
        }
        SEAM(10);
    }
    if (IN(11)) { PH_BEGIN
        pg8::Gemm g{(const bf16_t*)(a->ws + WS_YG), (const bf16_t*)(a->ws + WS_WGLU), DM / 2, DM / 2, DM / 2}; pg8::GridOrder S; S.init(M / 256, 2 * DM / 256, G, bx);
#if (DUP_MASK >> 11) & 1
        { pg8::EpiGLU E2{(bf16_t*)(a->ws + WS_UA), 1.f}; pg8::gemm_phase<1>(lds, g, S, E2, wave); }
#endif
        pg8::EpiGLU E{HN, 1.f / (W8_GU_SCALE * Y8_SCALE)};
        pg8::gemm_phase<1>(lds, g, S, E, wave);
        SEAM(11);
    }
    if (IN(12)) { PH_BEGIN REP(12) {
        unsigned char* HN2 = a->ws + WS_HN2; const float* RW = a->in[I_ROUTER]; unsigned char* RT = a->ws + WS_ROUTE;
        f32x4 gv[8];
#pragma unroll
        for (int j = 0; j < 8; ++j) gv[j] = ((const f32x4*)a->in[I_MOENORM])[lane + 64 * j];
        int cnt[NEXP];
#pragma unroll
        for (int e = 0; e < NEXP; ++e) cnt[e] = 0;
        LAS float* RWt = (LAS float*)(lds + 8 * 9216);
        for (int i = tid; i < DM * NEXP / 4; i += 512) { const f32x4 w4 = ((const f32x4*)RW)[i]; const int col = i >> 1, e0 = (i & 1) * 4;
            RWt[(e0 + 0) * DM + col] = w4.x; RWt[(e0 + 1) * DM + col] = w4.y; RWt[(e0 + 2) * DM + col] = w4.z; RWt[(e0 + 3) * DM + col] = w4.w; }
        __syncthreads();
        u32x2 vnx[8];
        if (gw < M) { const u32x2* xr = (const u32x2*)(HN + (size_t)gw * DM) + lane;
#pragma unroll
            for (int j = 0; j < 8; ++j) vnx[j] = xr[64 * j]; }
        for (int m = gw; m < M; m += NGW) {
            f32x4 v[8]; float sq_ = 0.f;
#pragma unroll
            for (int j = 0; j < 8; ++j) { v[j] = (f32x4){bflo(vnx[j].x), bfhi(vnx[j].x), bflo(vnx[j].y), bfhi(vnx[j].y)}; sq_ += (v[j].x * v[j].x + v[j].y * v[j].y) + (v[j].z * v[j].z + v[j].w * v[j].w); }
            if (m + NGW < M) { const u32x2* xr = (const u32x2*)(HN + (size_t)(m + NGW) * DM) + lane;
#pragma unroll
                for (int j = 0; j < 8; ++j) vnx[j] = xr[64 * j]; }
            const float rstd = rsqrtf(wave_sum(sq_) * (1.f / DM) + EPS);
            float lg[NEXP];
#pragma unroll
            for (int e = 0; e < NEXP; ++e) lg[e] = 0.f;
            LAS float* tb = (LAS float*)(lds + wave * 9216);
#pragma unroll
            for (int j = 0; j < 8; ++j) {
                const float t0 = v[j].x * rstd * gv[j].x, t1 = v[j].y * rstd * gv[j].y, t2 = v[j].z * rstd * gv[j].z, t3 = v[j].w * rstd * gv[j].w;
                *(LAS f32x4*)(tb + ((lane >> 3) + 8 * j) * 36 + 4 * (lane & 7)) = (f32x4){t0, t1, t2, t3};
#pragma unroll
                for (int e = 0; e < NEXP; ++e) { const f32x4 w4 = *(const LAS f32x4*)(RWt + e * DM + 4 * lane + 256 * j);
                    lg[e] += t0 * w4.x; lg[e] += t1 * w4.y; lg[e] += t2 * w4.z; lg[e] += t3 * w4.w; }
            }
            { float x[32];
#pragma unroll
              for (int q = 0; q < 8; ++q) { const f32x4 t4 = *(const LAS f32x4*)(tb + lane * 36 + 4 * q); x[4 * q] = t4.x; x[4 * q + 1] = t4.y; x[4 * q + 2] = t4.z; x[4 * q + 3] = t4.w; }
              u32x6 pk; unsigned sb; quant_fp6_block(x, pk, sb);
              unsigned char* dst = HN2 + (size_t)m * DM + (lane >> 2) * 128 + (lane & 3) * 16;
              *(u32x4*)dst = (u32x4){pk[0], pk[1], pk[2], pk[3]}; *(u32x4*)(dst + 64) = (u32x4){pk[4], pk[5], sb, 0u}; }
#pragma unroll
            for (int e = 0; e < NEXP; ++e) lg[e] = wave_sum(lg[e]);
            int e1 = 0; float v1 = lg[0];
#pragma unroll
            for (int e = 1; e < NEXP; ++e) if (lg[e] > v1) { v1 = lg[e]; e1 = e; }
            int e2 = -1; float v2 = -3.0e38f;
#pragma unroll
            for (int e = 0; e < NEXP; ++e) if (e != e1 && lg[e] > v2) { v2 = lg[e]; e2 = e; }
            const float g1 = 1.f / (1.f + expf(v2 - v1)), g2 = 1.f - g1;
            if (lane == 0) { int* ri = (int*)(RT + (size_t)m * 24); ri[0] = e1; ri[1] = e2; ((float*)ri)[2] = g1; ((float*)ri)[3] = g2; }
#pragma unroll
            for (int e = 0; e < NEXP; ++e) cnt[e] += (e == e1 || e == e2) ? 1 : 0;
        }
        if (lane == 0 && rep_ == 0) {
#pragma unroll
            for (int e = 0; e < NEXP; ++e) if (cnt[e]) __hip_atomic_fetch_add(ctl + CW_ECNT + 64 * e, (unsigned)cnt[e], __ATOMIC_RELAXED, __HIP_MEMORY_SCOPE_AGENT);
        }
        }
        SEAM(12);
    }
    int ts[NEXP + 1];
    if (IN(13) || IN(14) || IN(15)) {
        ts[0] = 0;
#pragma unroll
        for (int e = 0; e < NEXP; ++e) { const unsigned c = __builtin_amdgcn_readfirstlane(__hip_atomic_load(ctl + CW_ECNT + 64 * e, __ATOMIC_RELAXED, __HIP_MEMORY_SCOPE_AGENT)); ts[e + 1] = ts[e] + (int)((c + 255u) >> 8); }
    }
    if (IN(13)) { PH_BEGIN
        unsigned char* RT = a->ws + WS_ROUTE; const unsigned char* HN2 = a->ws + WS_HN2; unsigned char* XP = a->ws + WS_XP;
        LAS int* slots = (LAS int*)lds;
        for (int blk = bx; blk < M / 128; blk += G) {
            if (wave < 2) {
                const int m = blk * 128 + wave * 64 + lane; int* ri = (int*)(RT + (size_t)m * 24);
                const int e1 = ri[0], e2 = ri[1]; int s1 = 0, s2 = 0;
#pragma unroll
                for (int e = 0; e < NEXP; ++e) {
                    const unsigned long long m1 = __ballot(e1 == e), m2 = __ballot(e2 == e);
                    const int c1 = __popcll(m1), c2 = __popcll(m2);
                    unsigned base = 0;
                    if (lane == 0 && (c1 + c2)) base = __hip_atomic_fetch_add(ctl + CW_EFILL + 64 * e, (unsigned)(c1 + c2), __ATOMIC_RELAXED, __HIP_MEMORY_SCOPE_AGENT);
                    base = (unsigned)__builtin_amdgcn_readfirstlane((int)base);
                    const unsigned long long lt = (1ull << lane) - 1ull;
                    if (e1 == e) s1 = ts[e] * 256 + (int)base + __popcll(m1 & lt);
                    if (e2 == e) s2 = ts[e] * 256 + (int)base + c1 + __popcll(m2 & lt);
                }
                ri[4] = s1; ri[5] = s2;
                slots[(wave * 64 + lane) * 2] = s1; slots[(wave * 64 + lane) * 2 + 1] = s2;
            }
            __syncthreads();
            { u32x4 xr[16][2];
#pragma unroll
              for (int i = 0; i < 16; ++i) { const u32x4* src = (const u32x4*)(HN2 + (size_t)(blk * 128 + wave * 16 + i) * DM) + lane; xr[i][0] = src[0]; xr[i][1] = src[64]; }
#pragma unroll
              for (int i = 0; i < 16; ++i) { const int tl = wave * 16 + i; const int s1 = slots[tl * 2], s2 = slots[tl * 2 + 1];
                u32x4* d1 = (u32x4*)(XP + (size_t)s1 * DM) + lane; u32x4* d2 = (u32x4*)(XP + (size_t)s2 * DM) + lane;
                d1[0] = xr[i][0]; d1[64] = xr[i][1]; d2[0] = xr[i][0]; d2[64] = xr[i][1]; } }
            __syncthreads();
        }
        SEAM(13);
    }
    if (IN(14)) { PH_BEGIN REP(14) {
        pg8::Gemm g{(const bf16_t*)(a->ws + WS_XP), (const bf16_t*)(a->ws + WS_WEGU), DM / 2, DM / 2, DM / 2};
        pg8::MoeOrder<56> S; S.go.init(ts[NEXP], 56, G, bx);
#pragma unroll
        for (int e = 0; e <= NEXP; ++e) S.ts[e] = ts[e];
        pg8::EpiSwiGLU8<56> E{a->ws + WS_ACTM, DFE, 1.f};
        pg8::gemm_phase<2>(lds, g, S, E, wave);
        }
        SEAM(14);
    }
    if (IN(15)) { PH_BEGIN REP(15) {
        const int TM = (G == 256 && ts[NEXP] > 256) ? 256 : ts[NEXP];
        { pg8::Gemm g{(const bf16_t*)(a->ws + WS_ACTM), (const bf16_t*)(a->ws + WS_WEDN), DFE / 2, DFE / 2, DFE / 2};
          pg8::MoeOrder<8> S; S.go.init(TM, 8, G, bx, 1);
#pragma unroll
          for (int e = 0; e <= NEXP; ++e) S.ts[e] = ts[e];
          pg8::EpiBf16Plain<8> E{(bf16_t*)(a->ws + WS_YP), DM, 1.f / W8_DN_SCALE};
          pg8::gemm_phase<1>(lds, g, S, E, wave); }
        { const int nq = (ts[NEXP] - TM) * 32;
          const int qu = bx;
          if (qu < nq) {
            const int pm = TM + (qu >> 5), pnl = (qu >> 2) & 7, q = qu & 3; int e = 0;
#pragma unroll
            for (int k = 1; k < NEXP; ++k) e += (pm >= ts[k]) ? 1 : 0;
            pg8::Gemm g{(const bf16_t*)(a->ws + WS_ACTM + (size_t)q * (DFE / 4)), (const bf16_t*)(a->ws + WS_WEDN + (size_t)q * (DFE / 4)), DFE / 2, DFE / 2, DFE / 8};
            pg8::ListOrder S{pm, e * 8 + pnl, 1};
            pg8::EpiPartF32 E{(float*)(a->ws + WS_XP) + (size_t)q * 2048 * DM, TM, 1.f / W8_DN_SCALE};
            pg8::gemm_phase<1>(lds, g, S, E, wave);
          } }
        }
        SEAM(15);
    }
    if (IN(16)) { PH_BEGIN
        const unsigned char* RT = a->ws + WS_ROUTE; const bf16_t* YP = (const bf16_t*)(a->ws + WS_YP); const float* PART = (const float*)(a->ws + WS_XP); constexpr size_t PQ4 = (size_t)2048 * DM / 4;
        const unsigned tmo = __hip_atomic_load(ctl + CW_BAR + XB_TMO, __ATOMIC_RELAXED, __HIP_MEMORY_SCOPE_AGENT);
        int split0;
        { int tt = 0;
#pragma unroll
          for (int e = 0; e < NEXP; ++e) { const unsigned c = __builtin_amdgcn_readfirstlane(__hip_atomic_load(ctl + CW_ECNT + 64 * e, __ATOMIC_RELAXED, __HIP_MEMORY_SCOPE_AGENT)); tt += (int)((c + 255u) >> 8); }
          split0 = ((G == 256 && tt > 256) ? 256 : tt) * 256; }
        f32x4 gv[8];
#pragma unroll
        for (int j = 0; j < 8; ++j) gv[j] = ((const f32x4*)a->in[I_FINALNORM])[lane + 64 * j];
        for (int m = gw; m < M; m += NGW) {
            const int* ri = (const int*)(RT + (size_t)m * 24); const float g1 = ((const float*)ri)[2], g2 = ((const float*)ri)[3]; const int s1 = ri[4], s2 = ri[5];
            f32x4* hr = (f32x4*)(H + (size_t)m * DM) + lane; const u32x2* hb = (const u32x2*)(HN + (size_t)m * DM) + lane;
            f32x4 v[8], c1[8], c2[8]; float s = 0.f;
#define P16_ROW(S_, C_) do { if ((S_) < split0) { const u32x2* yp_ = (const u32x2*)(YP + (size_t)(S_) * DM) + lane; \
                _Pragma("unroll") for (int j = 0; j < 8; ++j) { const u32x2 p = yp_[64 * j]; C_[j] = (f32x4){bflo(p.x), bfhi(p.x), bflo(p.y), bfhi(p.y)}; } } \
              else { const f32x4* pp_ = (const f32x4*)(PART + (size_t)((S_) - split0) * DM) + lane; \
                _Pragma("unroll") for (int j = 0; j < 8; ++j) C_[j] = (pp_[64 * j] + pp_[64 * j + PQ4]) + (pp_[64 * j + 2 * PQ4] + pp_[64 * j + 3 * PQ4]); } } while (0)
            P16_ROW(s1, c1); P16_ROW(s2, c2);
#undef P16_ROW
#pragma unroll
            for (int j = 0; j < 8; ++j) { const u32x2 p = hb[64 * j]; const f32x4 x = (f32x4){bflo(p.x), bfhi(p.x), bflo(p.y), bfhi(p.y)};
                v[j] = x + c1[j] * g1 + c2[j] * g2;
                s += (v[j].x * v[j].x + v[j].y * v[j].y) + (v[j].z * v[j].z + v[j].w * v[j].w); }
            float rstd = rsqrtf(wave_sum(s) * (1.f / DM) + EPS);
            if (tmo) rstd = __builtin_nanf("");
#pragma unroll
            for (int j = 0; j < 8; ++j) hr[64 * j] = v[j] * rstd * gv[j];
        }
    }
#undef IN
#undef SEAM
}

extern "C" void kernel_launch(void* const* d_in, const int* in_sizes, int n_in, void* d_out, int out_size, void* d_ws, size_t ws_size, hipStream_t stream) {
    static int grid = 0;
    if (grid == 0) {
        if (n_in != 30 || out_size != M * DM || ws_size < WS_END) { fprintf(stderr, "kernel_launch: unexpected shapes: n_in %d out %d ws %zu (need %zu)\n", n_in, out_size, ws_size, (size_t)WS_END); grid = -1; return; }
        int dev = 0, cus = 0, per_cu = 0;
        if (hipGetDevice(&dev) != hipSuccess || hipDeviceGetAttribute(&cus, hipDeviceAttributeMultiprocessorCount, dev) != hipSuccess) { grid = -1; return; }
        if (hipFuncSetAttribute((const void*)fwd_kernel, hipFuncAttributeMaxDynamicSharedMemorySize, LDS_BYTES) != hipSuccess) { fprintf(stderr, "kernel_launch: hipFuncSetAttribute failed\n"); grid = -1; return; }
        if (hipOccupancyMaxActiveBlocksPerMultiprocessor(&per_cu, (const void*)fwd_kernel, 512, LDS_BYTES) != hipSuccess || per_cu < 1) fprintf(stderr, "kernel_launch: occupancy query reports %d\n", per_cu);
        (void)hipGetLastError();
        grid = cus;
    }
    if (grid < 0) return;
    (void)hipMemsetAsync((char*)d_ws + WS_CTL, 0, CTL_ZERO_BYTES, stream);
    Args a{};
    for (int i = 0; i < 30; ++i) a.in[i] = (const float*)d_in[i];
    a.out = (float*)d_out; a.ws = (unsigned char*)d_ws;
#if MK_MULTI
    for (int p = 0; p < NPHASE; ++p) { a.ph_lo = p; a.ph_hi = p + 1; hipLaunchKernelGGL(fwd_kernel, dim3(grid), dim3(512), LDS_BYTES, stream, a); }
#else
    a.ph_lo = 0; a.ph_hi = NPHASE;
    hipLaunchKernelGGL(fwd_kernel, dim3(grid), dim3(512), LDS_BYTES, stream, a);
#endif
}
```

```cpp
#include <hip/hip_runtime.h>
#include <cstdio>
#include <cstdint>

#ifndef MK_MULTI
#define MK_MULTI 0
#endif

#define LAS __attribute__((address_space(3)))
typedef unsigned short bf16_t;
typedef short bf16x8 __attribute__((ext_vector_type(8)));
typedef short s16x4 __attribute__((ext_vector_type(4)));
typedef float f32x2 __attribute__((ext_vector_type(2)));
typedef float f32x4 __attribute__((ext_vector_type(4)));
typedef float f32x16 __attribute__((ext_vector_type(16)));
typedef unsigned u32x2 __attribute__((ext_vector_type(2)));
typedef unsigned u32x4 __attribute__((ext_vector_type(4)));
typedef __bf16 bf16x2_t __attribute__((ext_vector_type(2)));
typedef int i32x4 __attribute__((ext_vector_type(4)));
typedef int i32x8 __attribute__((ext_vector_type(8)));
typedef unsigned u32x6 __attribute__((ext_vector_type(6)));

__device__ __forceinline__ unsigned pk2(float lo, float hi) { f32x2 v = {lo, hi}; bf16x2_t b = __builtin_convertvector(v, bf16x2_t); return __builtin_bit_cast(unsigned, b); }
__device__ __forceinline__ unsigned pk4_fp8(float a, float b, float c, float d) { int r = __builtin_amdgcn_cvt_pk_fp8_f32(a, b, 0, false); r = __builtin_amdgcn_cvt_pk_fp8_f32(c, d, r, true); return (unsigned)r; }
__device__ __forceinline__ void quant_fp6_block(const float (&x)[32], u32x6& pack, unsigned& sb) {
    float amax = 0.f;
#pragma unroll
    for (int i = 0; i < 32; ++i) amax = fmaxf(amax, fabsf(x[i]));
    int e = (int)((__float_as_uint(amax) >> 23) & 0xffu) - 2; e = e < 0 ? 0 : e;
    const float inv = __uint_as_float((unsigned)(254 - e) << 23);
    f32x16 lo, hi;
#pragma unroll
    for (int i = 0; i < 16; ++i) { lo[i] = x[i] * inv; hi[i] = x[16 + i] * inv; }
    pack = __builtin_bit_cast(u32x6, __builtin_amdgcn_cvt_scalef32_2xpk16_fp6_f32(lo, hi, 1.0f));
    sb = (unsigned)e;
}
__device__ __forceinline__ float bf2f(unsigned short b) { return __uint_as_float(((unsigned)b) << 16); }
__device__ __forceinline__ float bflo(unsigned w) { return __uint_as_float(w << 16); }
__device__ __forceinline__ float bfhi(unsigned w) { return __uint_as_float(w & 0xffff0000u); }
__device__ __forceinline__ float fast_sigmoid(float x) { return __builtin_amdgcn_rcpf(1.f + __builtin_amdgcn_exp2f(-1.4426950408889634f * x)); }
__device__ __forceinline__ float gelu_tanh(float x) { const float t = x * x, p = t * -0.1029432410f + -2.3022082f; return x * __builtin_amdgcn_rcpf(1.f + __builtin_amdgcn_exp2f(x * p)); }
__device__ __forceinline__ float silu_f(float x) { return x * fast_sigmoid(x); }
__device__ __forceinline__ f32x2 swiglu2(f32x2 g, f32x2 u, float ka, float c) {
    const f32x2 x = g * u, ea = g * ka; f32x2 e; e.x = __builtin_amdgcn_exp2f(ea.x); e.y = __builtin_amdgcn_exp2f(ea.y);
    const f32x2 d = e * c + c; f32x2 r; r.x = __builtin_amdgcn_rcpf(d.x); r.y = __builtin_amdgcn_rcpf(d.y);
    return x * r;
}
__device__ __forceinline__ int lane_id_v() { int l; asm volatile("v_mbcnt_lo_u32_b32 %0, -1, 0\n\tv_mbcnt_hi_u32_b32 %0, -1, %0" : "=v"(l)); return l; }
template <int M> __device__ __forceinline__ float swz_xor(float v) { return __int_as_float(__builtin_amdgcn_ds_swizzle(__float_as_int(v), 0x1F | (M << 10))); }
__device__ __forceinline__ float half_sum(float v) { auto rr = __builtin_amdgcn_permlane32_swap(__float_as_uint(v), __float_as_uint(v), false, false); return __uint_as_float(rr[0]) + __uint_as_float(rr[1]); }
__device__ __forceinline__ float half_max(float v) { auto rr = __builtin_amdgcn_permlane32_swap(__float_as_uint(v), __float_as_uint(v), false, false); return fmaxf(__uint_as_float(rr[0]), __uint_as_float(rr[1])); }
__device__ __forceinline__ float wave_sum(float v) {
    v += swz_xor<1>(v); v += swz_xor<2>(v); v += swz_xor<4>(v); v += swz_xor<8>(v); v += swz_xor<16>(v);
    return half_sum(v);
}

constexpr int DM = 2048, NB = 16, SEQ = 2048, M = NB * SEQ;
constexpr int MIX_IN = 5120, DFF = 5632, NEXP = 8, DFE = 7168;
constexpr int S5G = 128, S5L = 32, S5ROWS = S5G * 1024, S5K = 768;
constexpr int MOE_ROWS = 2 * M + NEXP * 256;
constexpr float EPS = 1e-6f;
constexpr float YP8_SCALE = 8.f;
constexpr float Y8_SCALE = 8.f;
constexpr float A8_FFN_SCALE = 8.f;
constexpr float W8_GU_SCALE = 64.f, W8_DN_SCALE = 128.f;
constexpr float QSCALE = 0.125f * 1.4426950408889634f;

constexpr size_t MiB = (size_t)1 << 20;
constexpr size_t WS_CTL = 0, CTL_ZERO_BYTES = 1 * MiB;
constexpr size_t WS_ROUTE = 1 * MiB;
constexpr size_t WS_GMWS = 2 * MiB;
constexpr size_t WS_SL = 3 * MiB;
constexpr size_t WS_WIN = 8 * MiB;
constexpr size_t WS_WOUT = WS_WIN + 20 * MiB;
constexpr size_t WS_WGU = WS_WOUT + 8 * MiB;
constexpr size_t WS_WDN = WS_WGU + 44 * MiB;
constexpr size_t WS_WGLU = WS_WDN + 22 * MiB;
constexpr size_t WS_WEGU = WS_WGLU + 16 * MiB;
constexpr size_t WS_WEDN = WS_WEGU + 448 * MiB;
constexpr size_t WS_S5BY = WS_WEDN + 224 * MiB;
constexpr size_t WS_S5BZ = WS_S5BY + 96 * MiB;
constexpr size_t WS_ACT0 = WS_S5BZ + 32 * MiB;
constexpr size_t WS_HN = WS_ACT0;
constexpr size_t WS_PROJ = WS_HN + 128 * MiB;
constexpr size_t WS_O0 = WS_PROJ + 320 * MiB;
constexpr size_t WS_MIXED = WS_O0 + 128 * MiB;
constexpr size_t WS_ACT = WS_PROJ;
constexpr size_t WS_UA = WS_HN + 128 * MiB;
constexpr size_t WS_Z = WS_UA + 192 * MiB;
constexpr size_t WS_YG = WS_Z + 128 * MiB;
constexpr size_t WS_HN2 = WS_YG + 128 * MiB;
constexpr size_t WS_XP = WS_HN2 + 128 * MiB;
constexpr size_t WS_ACTM = WS_XP + 264 * MiB;
constexpr size_t WS_YP = WS_UA;
constexpr size_t WS_END = WS_ACTM + 924 * MiB;
constexpr int CW_BAR = 4096;
constexpr int CW_ECNT = 16384;
constexpr int CW_EFILL = 16384 + 1024;

constexpr int SCR_BYTES = 155648;
constexpr int LDSCTL_OFF = SCR_BYTES;
constexpr int LDS_BYTES = 159744;

namespace pg8 {
constexpr int BM = 256, BK = 64, HALF = 128, HTB = HALF * BK * 2, STAGE_BYTES = 8 * HTB, NXCD = 8, WGM = 8;
__host__ __device__ __forceinline__ int lds_byte(int r, int c) { const int st = (r >> 4) * 2 + (c >> 5), rr = r & 15, cc = c & 31, ob = rr * 64 + cc * 2; return st * 1024 + (ob ^ (((ob >> 9) & 1) << 5)); }
__host__ __device__ __forceinline__ void stage_rc(int b, int& R, int& C) { const int st = b / 1024, sb = b % 1024, swz = sb ^ (((sb >> 9) & 1) << 5); R = (st >> 1) * 16 + swz / 64; C = (st & 1) * 32 + (swz % 64) / 2; }
__host__ __device__ __forceinline__ int perm32(int rho) { const int n = rho >> 4, i = rho & 15; return 8 * (i >> 2) + 4 * n + (i & 3); }

struct Unit { int pm, pn; };
struct Gemm { const bf16_t* A; const bf16_t* Bt; int lda, ldb, K; };

struct GridOrder {
    int nM, nN, nwg, G, c, rev;
    __device__ void init(int nM_, int nN_, int G_, int c_, int rev_ = 0) { nM = nM_; nN = nN_; nwg = nM * nN; G = G_; c = c_; rev = rev_; }
    __device__ __forceinline__ bool next(int i, Unit& u) const {
        const int ni = (nwg - c + G - 1) / G; if (i >= ni) return false;
        const long L = (long)(rev ? ni - 1 - i : i) * G + c;
        int wgid = (int)L; { const int q = nwg / NXCD, r = nwg % NXCD, xcd = wgid % NXCD, off = wgid / NXCD; wgid = (xcd < r ? xcd * (q + 1) : r * (q + 1) + (xcd - r) * q) + off; }
        const int nig = WGM * nN, gid = wgid / nig, fm = gid * WGM, gsz = (nM - fm) < WGM ? (nM - fm) : WGM;
        u.pm = fm + ((wgid % nig) % gsz); u.pn = (wgid % nig) / gsz; return true;
    }
    __device__ __forceinline__ void a_ready(const Unit&) const {}
    __device__ __forceinline__ void done(const Unit&) const {}
};
template <int RM, int RN> struct BatchOrder {
    int nwg, G, c;
    __device__ void init(int ngroups, int G_, int c_) { nwg = ngroups * RM * RN; G = G_; c = c_; }
    __device__ bool next(int i, Unit& u) const {
        const long L = (long)i * G + c; if (L >= nwg) return false;
        int wgid = (int)L; { const int q = nwg / NXCD, xcd = wgid % NXCD, off = wgid / NXCD; wgid = xcd * q + off; }
        const int g = wgid / (RM * RN), w = wgid % (RM * RN);
        u.pm = g * RM + (w % RM); u.pn = g * RN + (w / RM); return true;
    }
    __device__ __forceinline__ void a_ready(const Unit&) const {}
    __device__ __forceinline__ void done(const Unit&) const {}
};
struct ListOrder {
    int pm, pn0, n;
    __device__ bool next(int i, Unit& u) const { if (i >= n) return false; u.pm = pm; u.pn = pn0 + i; return true; }
    __device__ __forceinline__ void a_ready(const Unit&) const {}
    __device__ __forceinline__ void done(const Unit&) const {}
};
template <int NT> struct MoeOrder {
    GridOrder go; int ts[NEXP + 1];
    __device__ bool next(int i, Unit& u) const {
        if (!go.next(i, u)) return false;
        int e = 0;
#pragma unroll
        for (int k = 1; k < NEXP; ++k) e += (u.pm >= ts[k]) ? 1 : 0;
        u.pn += e * NT; return true;
    }
    __device__ __forceinline__ void a_ready(const Unit&) const {}
    __device__ __forceinline__ void done(const Unit&) const {}
};

struct EpiProj {
    static constexpr bool PERM = true; static constexpr int NVM = 16;
    bf16_t* O;
    __device__ __forceinline__ void operator()(const f32x4 (&acc)[2][2][4][2], const Unit& u, int wr, int wc, int fr, int fq) const {
        const int row0 = u.pm * BM + wr * 64 + fr, col0 = u.pn * BM + wc * 32 + 8 * fq;
        const int mode = (u.pn < 8) ? 1 : (u.pn < 12 ? 2 : 0);
#pragma unroll
        for (int ai = 0; ai < 2; ++ai)
#pragma unroll
            for (int m = 0; m < 4; ++m) { bf16_t* rowp = O + (size_t)(row0 + ai * HALF + m * 16) * MIX_IN + col0;
#pragma unroll
                for (int bj = 0; bj < 2; ++bj) { f32x4 v0 = acc[ai][bj][m][0], v1 = acc[ai][bj][m][1];
                    if (mode == 1) {
#pragma unroll
                        for (int j = 0; j < 4; ++j) { v0[j] = gelu_tanh(v0[j]); v1[j] = gelu_tanh(v1[j]); } }
                    else if (mode == 2) { v0 = v0 * QSCALE; v1 = v1 * QSCALE; }
                    u32x4 w; w.x = pk2(v0[0], v0[1]); w.y = pk2(v0[2], v0[3]); w.z = pk2(v1[0], v1[1]); w.w = pk2(v1[2], v1[3]);
                    *(u32x4*)(rowp + bj * HALF) = w; } }
    }
};
struct EpiResF32 {
    static constexpr bool PERM = false; static constexpr int NVM = 32;
    const float* res; float* out;
    __device__ __forceinline__ void operator()(const f32x4 (&acc)[2][2][4][2], const Unit& u, int wr, int wc, int fr, int fq) const {
        const int row0 = u.pm * BM + wr * 64 + fr, col0 = u.pn * BM + wc * 32 + 4 * fq;
        f32x4 r0[8], r1[8];
#define ER_OFF(G, mm) ((size_t)(row0 + ((G) >> 1) * HALF + (2 * ((G) & 1) + (mm)) * 16) * DM + col0)
#define ER_LOAD(G, R) do { _Pragma("unroll") for (int mm = 0; mm < 2; ++mm) _Pragma("unroll") for (int bj = 0; bj < 2; ++bj) _Pragma("unroll") for (int n = 0; n < 2; ++n) \
            R[mm * 4 + bj * 2 + n] = *(const f32x4*)(res + ER_OFF(G, mm) + bj * HALF + n * 16); } while (0)
#define ER_STORE(G, R) do { _Pragma("unroll") for (int mm = 0; mm < 2; ++mm) _Pragma("unroll") for (int bj = 0; bj < 2; ++bj) _Pragma("unroll") for (int n = 0; n < 2; ++n) \
            *(f32x4*)(out + ER_OFF(G, mm) + bj * HALF + n * 16) = R[mm * 4 + bj * 2 + n] + acc[(G) >> 1][bj][2 * ((G) & 1) + mm][n]; } while (0)
        ER_LOAD(0, r0); ER_LOAD(1, r1);
        ER_STORE(0, r0); ER_LOAD(2, r0);
        ER_STORE(1, r1); ER_LOAD(3, r1);
        ER_STORE(2, r0); ER_STORE(3, r1);
#undef ER_OFF
#undef ER_LOAD
#undef ER_STORE
    }
};
struct EpiResSq {
    static constexpr bool PERM = true; static constexpr int NVM = 32;
    const float* res; unsigned char* ws;
    __device__ __forceinline__ void operator()(const f32x4 (&acc)[2][2][4][2], const Unit& u, int wr, int wc, int fr, int fq) const {
        const int row0 = u.pm * BM + wr * 64 + fr, col0 = u.pn * BM + wc * 32 + 8 * fq;
        bf16_t* const hn = (bf16_t*)(ws + WS_HN); float* const sl = (float*)(ws + WS_SL);
        f32x4 r0[8], r1[8];
#define EQ_OFF(G, mm) ((size_t)(row0 + ((G) >> 1) * HALF + (2 * ((G) & 1) + (mm)) * 16) * DM + col0)
#define EQ_LOAD(G, R) do { _Pragma("unroll") for (int mm = 0; mm < 2; ++mm) _Pragma("unroll") for (int bj = 0; bj < 2; ++bj) _Pragma("unroll") for (int n = 0; n < 2; ++n) \
            R[mm * 4 + bj * 2 + n] = *(const f32x4*)(res + EQ_OFF(G, mm) + bj * HALF + n * 4); } while (0)
#define EQ_STORE(G, R) do { _Pragma("unroll") for (int mm = 0; mm < 2; ++mm) { float q_ = 0.f; _Pragma("unroll") for (int bj = 0; bj < 2; ++bj) { \
            const f32x4 o0 = R[mm * 4 + bj * 2] + acc[(G) >> 1][bj][2 * ((G) & 1) + mm][0], o1 = R[mm * 4 + bj * 2 + 1] + acc[(G) >> 1][bj][2 * ((G) & 1) + mm][1]; \
            u32x4 w; w.x = pk2(o0[0], o0[1]); w.y = pk2(o0[2], o0[3]); w.z = pk2(o1[0], o1[1]); w.w = pk2(o1[2], o1[3]); *(u32x4*)(hn + EQ_OFF(G, mm) + bj * HALF) = w; \
            q_ += ((o0[0] * o0[0] + o0[1] * o0[1]) + (o0[2] * o0[2] + o0[3] * o0[3])) + ((o1[0] * o1[0] + o1[1] * o1[1]) + (o1[2] * o1[2] + o1[3] * o1[3])); } \
            q_ += swz_xor<16>(q_); q_ = half_sum(q_);                                                          \
            if (fq == 0) sl[(size_t)(row0 + ((G) >> 1) * HALF + (2 * ((G) & 1) + mm) * 16) * 32 + u.pn * 4 + wc] = q_; } } while (0)
        EQ_LOAD(0, r0); EQ_LOAD(1, r1);
        EQ_STORE(0, r0); EQ_LOAD(2, r0);
        EQ_STORE(1, r1); EQ_LOAD(3, r1);
        EQ_STORE(2, r0); EQ_STORE(3, r1);
#undef EQ_LOAD
#undef EQ_STORE
#undef EQ_OFF
    }
};
struct EpiResBf {
    static constexpr bool PERM = true; static constexpr int NVM = 32;
    bf16_t* io; float s;
    __device__ __forceinline__ void operator()(const f32x4 (&acc)[2][2][4][2], const Unit& u, int wr, int wc, int fr, int fq) const {
        const int row0 = u.pm * BM + wr * 64 + fr, col0 = u.pn * BM + wc * 32 + 8 * fq;
        u32x4 r[16];
#pragma unroll
        for (int ai = 0; ai < 2; ++ai)
#pragma unroll
            for (int m = 0; m < 4; ++m)
#pragma unroll
                for (int bj = 0; bj < 2; ++bj) r[ai * 8 + m * 2 + bj] = *(const u32x4*)(io + (size_t)(row0 + ai * HALF + m * 16) * DM + col0 + bj * HALF);
#pragma unroll
        for (int ai = 0; ai < 2; ++ai)
#pragma unroll
            for (int m = 0; m < 4; ++m)
#pragma unroll
                for (int bj = 0; bj < 2; ++bj) { const u32x4 w = r[ai * 8 + m * 2 + bj]; bf16_t* op = io + (size_t)(row0 + ai * HALF + m * 16) * DM + col0 + bj * HALF;
                    const f32x4 a0 = acc[ai][bj][m][0] * s, a1 = acc[ai][bj][m][1] * s; u32x4 o;
                    o.x = pk2(a0[0] + bflo(w.x), a0[1] + bfhi(w.x)); o.y = pk2(a0[2] + bflo(w.y), a0[3] + bfhi(w.y));
                    o.z = pk2(a1[0] + bflo(w.z), a1[1] + bfhi(w.z)); o.w = pk2(a1[2] + bflo(w.w), a1[3] + bfhi(w.w));
                    *(u32x4*)op = o; }
    }
};
template <int NT> struct EpiSwiGLU {
    static constexpr bool PERM = true; static constexpr int NVM = 8;
    bf16_t* O; int ldo; const LAS float* rst; int pmA;
    __device__ __forceinline__ void operator()(const f32x4 (&acc)[2][2][4][2], const Unit& u, int wr, int wc, int fr, int fq) const {
        const int row0 = u.pm * BM + wr * 64 + fr, col0 = (u.pn % NT) * HALF + wc * 32 + 8 * fq;
        const LAS float* rt = rst + ((u.pm == pmA) ? 0 : 256) + wr * 64 + fr;
#pragma unroll
        for (int ai = 0; ai < 2; ++ai)
#pragma unroll
            for (int m = 0; m < 4; ++m) { bf16_t* rowp = O + (size_t)(row0 + ai * HALF + m * 16) * ldo + col0;
                const float rs = rt[ai * HALF + m * 16];
                const f32x4 g0 = acc[ai][0][m][0] * rs, g1 = acc[ai][0][m][1] * rs, u0 = acc[ai][1][m][0] * rs, u1 = acc[ai][1][m][1] * rs;
                const f32x2 a0 = swiglu2((f32x2){g0[0], g0[1]}, (f32x2){u0[0], u0[1]}, -1.4426950408889634f, 1.f), a1 = swiglu2((f32x2){g0[2], g0[3]}, (f32x2){u0[2], u0[3]}, -1.4426950408889634f, 1.f);
                const f32x2 a2 = swiglu2((f32x2){g1[0], g1[1]}, (f32x2){u1[0], u1[1]}, -1.4426950408889634f, 1.f), a3 = swiglu2((f32x2){g1[2], g1[3]}, (f32x2){u1[2], u1[3]}, -1.4426950408889634f, 1.f);
                u32x4 w; w.x = pk2(a0.x, a0.y); w.y = pk2(a1.x, a1.y); w.z = pk2(a2.x, a2.y); w.w = pk2(a3.x, a3.y);
                *(u32x4*)rowp = w; }
    }
};
template <int NT> struct EpiSwiGLUr8 {
    static constexpr bool PERM = true; static constexpr int NVM = 8;
    unsigned char* O; int ldo; const LAS float* rst; int pmA; float AS;
    __device__ __forceinline__ void operator()(const f32x4 (&acc)[2][2][4][2], const Unit& u, int wr, int wc, int fr, int fq) const {
        const int row0 = u.pm * BM + wr * 64 + fr, col0 = (u.pn % NT) * HALF + wc * 32 + 8 * fq;
        const LAS float* rt = rst + ((u.pm == pmA) ? 0 : 256) + wr * 64 + fr;
#pragma unroll
        for (int ai = 0; ai < 2; ++ai)
#pragma unroll
            for (int m = 0; m < 4; ++m) { unsigned char* rowp = O + (size_t)(row0 + ai * HALF + m * 16) * ldo + col0;
                const float rs = rt[ai * HALF + m * 16];
                const f32x4 g0 = acc[ai][0][m][0] * rs, g1 = acc[ai][0][m][1] * rs, u0 = acc[ai][1][m][0] * (rs * AS), u1 = acc[ai][1][m][1] * (rs * AS);
                const f32x2 a0 = swiglu2((f32x2){g0[0], g0[1]}, (f32x2){u0[0], u0[1]}, -1.4426950408889634f, 1.f), a1 = swiglu2((f32x2){g0[2], g0[3]}, (f32x2){u0[2], u0[3]}, -1.4426950408889634f, 1.f);
                const f32x2 a2 = swiglu2((f32x2){g1[0], g1[1]}, (f32x2){u1[0], u1[1]}, -1.4426950408889634f, 1.f), a3 = swiglu2((f32x2){g1[2], g1[3]}, (f32x2){u1[2], u1[3]}, -1.4426950408889634f, 1.f);
                u32x2 w; w.x = pk4_fp8(a0.x, a0.y, a1.x, a1.y); w.y = pk4_fp8(a2.x, a2.y, a3.x, a3.y);
                *(u32x2*)rowp = w; }
    }
};
struct EpiZ {
    static constexpr bool PERM = true; static constexpr int NVM = 16;
    bf16_t* out;
    __device__ __forceinline__ void operator()(const f32x4 (&acc)[2][2][4][2], const Unit& u, int wr, int wc, int fr, int fq) const {
        const int row0 = u.pm * BM + wr * 64 + fr, col0 = wc * 32 + 8 * fq;
#pragma unroll
        for (int ai = 0; ai < 2; ++ai)
#pragma unroll
            for (int m = 0; m < 4; ++m) { bf16_t* rowp = out + (size_t)(row0 + ai * HALF + m * 16) * 256 + col0;
#pragma unroll
                for (int bj = 0; bj < 2; ++bj) { const f32x4 v0 = acc[ai][bj][m][0], v1 = acc[ai][bj][m][1];
                    u32x4 w; w.x = pk2(v0[0], v0[1]); w.y = pk2(v0[2], v0[3]); w.z = pk2(v1[0], v1[1]); w.w = pk2(v1[2], v1[3]);
                    *(u32x4*)(rowp + bj * HALF) = w; } }
    }
};
struct EpiS5Y {
    static constexpr bool PERM = true; static constexpr int NVM = 16;
    unsigned char* O;
    __device__ __forceinline__ void operator()(const f32x4 (&acc)[2][2][4][2], const Unit& u, int wr, int wc, int fr, int fq) const {
        const int g = u.pm >> 2, brow0 = (u.pm & 3) * BM + wr * 64 + fr, ncol0 = (u.pn & 1) * BM + wc * 32 + 8 * fq;
#pragma unroll
        for (int ai = 0; ai < 2; ++ai)
#pragma unroll
            for (int m = 0; m < 4; ++m) { const int brow = brow0 + ai * HALF + m * 16, b = brow >> 6, ch = brow & 63;
#pragma unroll
                for (int bj = 0; bj < 2; ++bj) { const int n = ncol0 + bj * HALF, t = n >> 4, co = n & 15;
                    f32x4 v0 = acc[ai][bj][m][0], v1 = acc[ai][bj][m][1];
#pragma unroll
                    for (int j = 0; j < 4; ++j) { v0[j] = gelu_tanh(v0[j]) * Y8_SCALE; v1[j] = gelu_tanh(v1[j]) * Y8_SCALE; }
                    u32x2 w; w.x = pk4_fp8(v0[0], v0[1], v0[2], v0[3]); w.y = pk4_fp8(v1[0], v1[1], v1[2], v1[3]);
                    *(u32x2*)(O + (size_t)(b * SEQ + ch * S5L + t) * DM + g * 16 + co) = w; } }
    }
};
struct EpiGLU {
    static constexpr bool PERM = true; static constexpr int NVM = 16;
    bf16_t* io; float s;
    __device__ __forceinline__ void operator()(const f32x4 (&acc)[2][2][4][2], const Unit& u, int wr, int wc, int fr, int fq) const {
        const int row0 = u.pm * BM + wr * 64 + fr, col0 = u.pn * HALF + wc * 32 + 8 * fq;
        u32x4 r[8];
#pragma unroll
        for (int ai = 0; ai < 2; ++ai)
#pragma unroll
            for (int m = 0; m < 4; ++m) r[ai * 4 + m] = *(const u32x4*)(io + (size_t)(row0 + ai * HALF + m * 16) * DM + col0);
#pragma unroll
        for (int ai = 0; ai < 2; ++ai)
#pragma unroll
            for (int m = 0; m < 4; ++m) { const u32x4 w = r[ai * 4 + m]; const f32x4 v0 = acc[ai][0][m][0] * s, v1 = acc[ai][0][m][1] * s, g0 = acc[ai][1][m][0] * s, g1 = acc[ai][1][m][1] * s; u32x4 o;
                o.x = pk2(bflo(w.x) + v0[0] * fast_sigmoid(g0[0]), bfhi(w.x) + v0[1] * fast_sigmoid(g0[1])); o.y = pk2(bflo(w.y) + v0[2] * fast_sigmoid(g0[2]), bfhi(w.y) + v0[3] * fast_sigmoid(g0[3]));
                o.z = pk2(bflo(w.z) + v1[0] * fast_sigmoid(g1[0]), bfhi(w.z) + v1[1] * fast_sigmoid(g1[1])); o.w = pk2(bflo(w.w) + v1[2] * fast_sigmoid(g1[2]), bfhi(w.w) + v1[3] * fast_sigmoid(g1[3]));
                *(u32x4*)(io + (size_t)(row0 + ai * HALF + m * 16) * DM + col0) = o; }
    }
};
template <int NT> struct EpiSwiGLU8 {
    static constexpr bool PERM = true; static constexpr int NVM = 4;
    unsigned char* O; int ldo; float s;
    __device__ __forceinline__ void operator()(const f32x4 (&acc)[2][2][4][2], const Unit& u, int wr, int wc, int fr, int fq) const {
        const int row0 = u.pm * BM + wr * 64 + fr, col0 = (u.pn % NT) * HALF + wc * 32 + 8 * fq;
        const float ka = -1.4426950408889634f * s, c = 1.f / (s * s);
        unsigned char* rowp = O + (size_t)row0 * ldo + (col0 & ~15);
#pragma unroll
        for (int ai = 0; ai < 2; ++ai)
#pragma unroll
            for (int mp = 0; mp < 2; ++mp) {
                u32x2 w[2];
#pragma unroll
                for (int k = 0; k < 2; ++k) { const int m = 2 * mp + k;
                    const f32x4 g0 = acc[ai][0][m][0], g1 = acc[ai][0][m][1], u0 = acc[ai][1][m][0], u1 = acc[ai][1][m][1];
                    const f32x2 a0 = swiglu2((f32x2){g0[0], g0[1]}, (f32x2){u0[0], u0[1]}, ka, c), a1 = swiglu2((f32x2){g0[2], g0[3]}, (f32x2){u0[2], u0[3]}, ka, c);
                    const f32x2 a2 = swiglu2((f32x2){g1[0], g1[1]}, (f32x2){u1[0], u1[1]}, ka, c), a3 = swiglu2((f32x2){g1[2], g1[3]}, (f32x2){u1[2], u1[3]}, ka, c);
                    w[k].x = pk4_fp8(a0.x, a0.y, a1.x, a1.y); w[k].y = pk4_fp8(a2.x, a2.y, a3.x, a3.y); }
                const bool odd = fq & 1;
                const u32x2 snd = odd ? w[0] : w[1];
                u32x2 rcv; rcv.x = (unsigned)__builtin_amdgcn_ds_swizzle((int)snd.x, 0x1F | (16 << 10)); rcv.y = (unsigned)__builtin_amdgcn_ds_swizzle((int)snd.y, 0x1F | (16 << 10));
                const u32x4 v = odd ? (u32x4){rcv.x, rcv.y, w[1].x, w[1].y} : (u32x4){w[0].x, w[0].y, rcv.x, rcv.y};
                *(u32x4*)(rowp + (size_t)(ai * HALF + (2 * mp + (odd ? 1 : 0)) * 16) * ldo) = v; }
    }
};
template <int NT> struct EpiFp8Plain {
    static constexpr bool PERM = true; static constexpr int NVM = 16;
    unsigned char* O; int ldo; float s;
    __device__ __forceinline__ void operator()(const f32x4 (&acc)[2][2][4][2], const Unit& u, int wr, int wc, int fr, int fq) const {
        const int row0 = u.pm * BM + wr * 64 + fr, col0 = (u.pn % NT) * BM + wc * 32 + 8 * fq;
#pragma unroll
        for (int ai = 0; ai < 2; ++ai)
#pragma unroll
            for (int m = 0; m < 4; ++m) { unsigned char* rowp = O + (size_t)(row0 + ai * HALF + m * 16) * ldo + col0;
#pragma unroll
                for (int bj = 0; bj < 2; ++bj) { const f32x4 v0 = acc[ai][bj][m][0] * s, v1 = acc[ai][bj][m][1] * s;
                    u32x2 w; w.x = pk4_fp8(v0[0], v0[1], v0[2], v0[3]); w.y = pk4_fp8(v1[0], v1[1], v1[2], v1[3]);
                    *(u32x2*)(rowp + bj * HALF) = w; } }
    }
};
template <int NT> struct EpiBf16Plain {
    static constexpr bool PERM = true; static constexpr int NVM = 16;
    bf16_t* O; int ldo; float s;
    __device__ __forceinline__ void operator()(const f32x4 (&acc)[2][2][4][2], const Unit& u, int wr, int wc, int fr, int fq) const {
        const int row0 = u.pm * BM + wr * 64 + fr, col0 = (u.pn % NT) * BM + wc * 32 + 8 * fq;
#pragma unroll
        for (int ai = 0; ai < 2; ++ai)
#pragma unroll
            for (int m = 0; m < 4; ++m) { bf16_t* rowp = O + (size_t)(row0 + ai * HALF + m * 16) * ldo + col0;
#pragma unroll
                for (int bj = 0; bj < 2; ++bj) { const f32x4 v0 = acc[ai][bj][m][0] * s, v1 = acc[ai][bj][m][1] * s;
                    u32x4 w; w.x = pk2(v0[0], v0[1]); w.y = pk2(v0[2], v0[3]); w.z = pk2(v1[0], v1[1]); w.w = pk2(v1[2], v1[3]);
                    *(u32x4*)(rowp + bj * HALF) = w; } }
    }
};

struct EpiPartF32 {
    static constexpr bool PERM = false; static constexpr int NVM = 32;
    float* out; int pm0; float s;
    __device__ __forceinline__ void operator()(const f32x4 (&acc)[2][2][4][2], const Unit& u, int wr, int wc, int fr, int fq) const {
        const int row0 = (u.pm - pm0) * BM + wr * 64 + fr, col0 = (u.pn & 7) * BM + wc * 32 + 4 * fq;
#pragma unroll
        for (int ai = 0; ai < 2; ++ai)
#pragma unroll
            for (int m = 0; m < 4; ++m) { float* rowp = out + (size_t)(row0 + ai * HALF + m * 16) * DM + col0;
#pragma unroll
                for (int bj = 0; bj < 2; ++bj)
#pragma unroll
                    for (int n = 0; n < 2; ++n) *(f32x4*)(rowp + bj * HALF + n * 16) = acc[ai][bj][m][n] * s; }
    }
};

template <int FMT = 0  , class Epi, class Sched>
__device__ __forceinline__ void gemm_phase(LAS unsigned char* lds, const Gemm g, const Sched& S, const Epi& E, const int wid) {
    const int lane = lane_id_v(), tid = wid * 64 + lane, wr = wid >> 2, wc = wid & 3, fr = lane & 15, fq = lane >> 4;
    const int K = g.K, nt = K / BK;
    unsigned voffA[2], voffB[2];
#pragma unroll
    for (int i = 0; i < 2; ++i) { int R, C; stage_rc(tid * 16 + i * 8192, R, C); const int Rb = Epi::PERM ? ((R & ~31) + perm32(R & 31)) : R;
        voffA[i] = (unsigned)(R * g.lda + C) * 2u; voffB[i] = (unsigned)(Rb * g.ldb + C) * 2u; }
    const size_t kstep = (size_t)(BK * 2);
    const size_t hsA = (size_t)HALF * g.lda * 2, hsB = (size_t)HALF * g.ldb * 2;
    const size_t tsA = 2 * hsA, tsB = 2 * hsB;
    const unsigned ldsw = (unsigned)wid * 1024u;
    const int aoff = lds_byte(wr * 64 + fr, fq * 8), boff = lds_byte(wc * 32 + fr, fq * 8);
    unsigned abase_u = (unsigned)(uintptr_t)lds + (unsigned)aoff, bbase_u = (unsigned)(uintptr_t)lds + (unsigned)(4 * HTB + boff);
    asm volatile("" : "+v"(abase_u), "+v"(bbase_u));
    const LAS unsigned char* abase = (const LAS unsigned char*)(uintptr_t)abase_u; const LAS unsigned char* bbase = (const LAS unsigned char*)(uintptr_t)bbase_u;
#define PG8_SA(b, h) (((b) * 2 + (h)) * HTB)
#define PG8_SB(b, h) ((4 + (b) * 2 + (h)) * HTB)
#define PG8_STAGE(bufoff, gbase, voff) do { _Pragma("unroll") for (int _i = 0; _i < 2; ++_i) { unsigned _vo = (voff)[_i]; asm volatile("" : "+v"(_vo));   \
        __builtin_amdgcn_global_load_lds((const unsigned*)((const char*)(gbase) + _vo), (LAS unsigned*)(lds + (bufoff) + ldsw + _i * 8192), 16, 0, 0); } } while (0)
#define PG8_RDA(off) (*(const LAS i32x4*)(abase + (off)))
#define PG8_RDB(off) (*(const LAS i32x4*)(bbase + (off)))
#define PG8_LDA(dst, b, h) do { _Pragma("unroll") for (int m = 0; m < 4; ++m) dst[m] = __builtin_shufflevector(PG8_RDA(PG8_SA(b, h) + m * 2048), PG8_RDA(PG8_SA(b, h) + m * 2048 + 1024), 0, 1, 2, 3, 4, 5, 6, 7); } while (0)
#define PG8_LDB(dst, b, h) do { _Pragma("unroll") for (int n = 0; n < 2; ++n) dst[n] = __builtin_shufflevector(PG8_RDB(PG8_SB(b, h) - 4 * HTB + n * 2048), PG8_RDB(PG8_SB(b, h) - 4 * HTB + n * 2048 + 1024), 0, 1, 2, 3, 4, 5, 6, 7); } while (0)
#define PG8_LO(x) __builtin_bit_cast(bf16x8, __builtin_shufflevector((x), (x), 0, 1, 2, 3))
#define PG8_HI(x) __builtin_bit_cast(bf16x8, __builtin_shufflevector((x), (x), 4, 5, 6, 7))
#define PG8_MMA(ai, bj, At, Bt) do { __builtin_amdgcn_s_setprio(1); _Pragma("unroll") for (int m = 0; m < 4; ++m) _Pragma("unroll") for (int n = 0; n < 2; ++n) { \
        if constexpr (FMT == 1) acc[ai][bj][m][n] = __builtin_amdgcn_mfma_scale_f32_16x16x128_f8f6f4(Bt[n], At[m], acc[ai][bj][m][n], 0, 0, 0, 0, 0, 0);   \
        else if constexpr (FMT == 2) acc[ai][bj][m][n] = __builtin_amdgcn_mfma_scale_f32_16x16x128_f8f6f4(Bt[n], At[m], acc[ai][bj][m][n], 2, 2, 0, Bt[n][6], 0, At[m][6]);   \
        else { acc[ai][bj][m][n] = __builtin_amdgcn_mfma_f32_16x16x32_bf16(PG8_LO(Bt[n]), PG8_LO(At[m]), acc[ai][bj][m][n], 0, 0, 0); \
               acc[ai][bj][m][n] = __builtin_amdgcn_mfma_f32_16x16x32_bf16(PG8_HI(Bt[n]), PG8_HI(At[m]), acc[ai][bj][m][n], 0, 0, 0); } } \
        __builtin_amdgcn_s_setprio(0); } while (0)
#define PG8_WAIT_V(n) asm volatile("s_waitcnt vmcnt(" #n ")" ::: "memory")
#define PG8_WAIT_L(n) asm volatile("s_waitcnt lgkmcnt(" #n ")" ::: "memory")
#define PG8_BAR __builtin_amdgcn_s_barrier()
#define PG8_SCHED __builtin_amdgcn_sched_barrier(0)
    Unit cur, nxt; int ui = 0;
    if (!S.next(0, cur)) return;
    f32x4 acc[2][2][4][2];
#pragma unroll
    for (int a = 0; a < 2; ++a)
#pragma unroll
        for (int b = 0; b < 2; ++b)
#pragma unroll
            for (int m = 0; m < 4; ++m)
#pragma unroll
                for (int n = 0; n < 2; ++n) acc[a][b][m][n] = (f32x4){0.f, 0.f, 0.f, 0.f};
    i32x8 At[4], B0[2], B1[2];
    const char* cA = (const char*)g.A + (size_t)cur.pm * tsA; const char* cB = (const char*)g.Bt + (size_t)cur.pn * tsB;
    S.a_ready(cur);
    PG8_STAGE(PG8_SB(0, 0), cB, voffB); PG8_STAGE(PG8_SB(0, 1), cB + hsB, voffB); PG8_STAGE(PG8_SA(0, 0), cA, voffA); PG8_STAGE(PG8_SA(0, 1), cA + hsA, voffA);
    if (wr == 1) PG8_BAR;
    PG8_WAIT_V(2); PG8_BAR;
    PG8_STAGE(PG8_SB(1, 0), cB + kstep, voffB); PG8_STAGE(PG8_SA(1, 0), cA + kstep, voffA); PG8_STAGE(PG8_SB(1, 1), cB + hsB + kstep, voffB);
    PG8_WAIT_V(6); PG8_BAR;
    for (;;) {
        const bool has_next = S.next(ui + 1, nxt);
        const char* nA = has_next ? (const char*)g.A + (size_t)nxt.pm * tsA : cA; const char* nB = has_next ? (const char*)g.Bt + (size_t)nxt.pn * tsB : cB;
#define PG8_TRIP(W1, W2) do { \
            const bool last = (t == nt - 2); \
            const char* a1 = cA + (size_t)(t + 1) * kstep; \
            const char* a2 = last ? nA : cA + (size_t)(t + 2) * kstep; const char* b2 = last ? nB : cB + (size_t)(t + 2) * kstep; \
            const char* a3 = a2 + kstep; const char* b3 = b2 + kstep; \
            if (last && has_next) S.a_ready(nxt); \
            PG8_LDB(B0, 0, 0); PG8_LDB(B1, 0, 1); PG8_SCHED; PG8_LDA(At, 0, 0); PG8_STAGE(PG8_SA(1, 1), a1 + hsA, voffA); \
            W1; PG8_WAIT_L(0); PG8_BAR; PG8_MMA(0, 0, At, B0); PG8_MMA(0, 1, At, B1); PG8_BAR; PG8_SCHED; \
            PG8_LDA(At, 0, 1); PG8_STAGE(PG8_SB(0, 0), b2, voffB); PG8_STAGE(PG8_SB(0, 1), b2 + hsB, voffB); PG8_STAGE(PG8_SA(0, 0), a2, voffA); \
            W2; PG8_WAIT_L(0); PG8_BAR; PG8_MMA(1, 0, At, B0); PG8_MMA(1, 1, At, B1); PG8_BAR; PG8_SCHED; \
            PG8_LDB(B0, 1, 0); PG8_LDB(B1, 1, 1); PG8_SCHED; PG8_LDA(At, 1, 0); PG8_STAGE(PG8_SA(0, 1), a2 + hsA, voffA); \
            PG8_WAIT_V(8); PG8_WAIT_L(0); PG8_BAR; PG8_MMA(0, 0, At, B0); PG8_MMA(0, 1, At, B1); PG8_BAR; PG8_SCHED; \
            PG8_LDA(At, 1, 1); PG8_STAGE(PG8_SB(1, 0), b3, voffB); PG8_STAGE(PG8_SB(1, 1), b3 + hsB, voffB); PG8_STAGE(PG8_SA(1, 0), a3, voffA); \
            PG8_WAIT_V(8); PG8_WAIT_L(0); PG8_BAR; PG8_MMA(1, 0, At, B0); PG8_MMA(1, 1, At, B1); PG8_BAR; PG8_SCHED; } while (0)
#define PG8_WAIT_VN(N) asm volatile("s_waitcnt vmcnt(%0)" :: "n"(N) : "memory")
        int t = 0;
        if (ui > 0) { PG8_TRIP(PG8_WAIT_VN(8 + Epi::NVM), PG8_WAIT_VN(8 + Epi::NVM)); t = 2; }
#pragma unroll 1
        for (; t < nt; t += 2) PG8_TRIP(PG8_WAIT_V(8), PG8_WAIT_V(8));
#undef PG8_TRIP
#undef PG8_WAIT_VN
        if (wr == 0) PG8_BAR;
        E(acc, cur, wr, wc, fr, fq); S.done(cur);
        if (!has_next) break;
#pragma unroll
        for (int a = 0; a < 2; ++a)
#pragma unroll
            for (int b = 0; b < 2; ++b)
#pragma unroll
                for (int m = 0; m < 4; ++m)
#pragma unroll
                    for (int n = 0; n < 2; ++n) acc[a][b][m][n] = (f32x4){0.f, 0.f, 0.f, 0.f};
        cur = nxt; cA = nA; cB = nB; ++ui;
        if (wr == 1) PG8_BAR;
    }
    PG8_WAIT_V(0);
    PG8_BAR;
#undef PG8_SA
#undef PG8_SB
#undef PG8_STAGE
#undef PG8_LDA
#undef PG8_LDB
#undef PG8_MMA
#undef PG8_LO
#undef PG8_HI
#undef PG8_RDA
#undef PG8_RDB
#undef PG8_WAIT_V
#undef PG8_WAIT_L
#undef PG8_BAR
#undef PG8_SCHED
}
}

#define XB_TMO      128
#define XB_XCNT(j)  (256  + 64 * (j))
#define XB_XSUB(j)  (1280 + 64 * (j))
#define XB_XGEN(j)  (2304 + 64 * (j))
#define XB_TOP      3328
#define XB_TOPGEN   3392
#define XCD_BAR_WORDS 3456
#define XB_SPIN_CAP (1u << 20)
__device__ __forceinline__ unsigned xb_ld(unsigned* p)              { return __hip_atomic_load(p, __ATOMIC_RELAXED, __HIP_MEMORY_SCOPE_AGENT); }
__device__ __forceinline__ unsigned xb_add(unsigned* p, unsigned v) { return __hip_atomic_fetch_add(p, v, __ATOMIC_RELAXED, __HIP_MEMORY_SCOPE_AGENT); }
__device__ __forceinline__ unsigned xb_xcc_id() { return (unsigned)__builtin_amdgcn_s_getreg((3 << 11) | 20) & 0xFu; }
#define XB_SPIN(cond, bar) do { unsigned _sp = 0; while (cond) { __builtin_amdgcn_s_sleep(1); \
    if ((++_sp & 255u) == 0u) { if (xb_ld(&(bar)[XB_TMO])) break; if (_sp > XB_SPIN_CAP) { atomicAdd(&(bar)[XB_TMO], 1u); break; } } } } while (0)
struct XcdBarrier { unsigned* bar; unsigned x; volatile LAS unsigned* st; };
__device__ __forceinline__ XcdBarrier xcd_barrier_post(unsigned* bar, volatile LAS unsigned* st, bool t0) {
    XcdBarrier b; b.bar = bar; b.x = xb_xcc_id(); b.st = st;
    if (t0) (void)xb_add(&bar[XB_XCNT(b.x)], 1u);
    return b;
}
__device__ __forceinline__ void xcd_barrier_complete(unsigned* bar, unsigned x, unsigned& nloc, unsigned& nx) {
    const unsigned G = gridDim.x * gridDim.y * gridDim.z;
    unsigned sum, cnt, mine, sp = 0u;
    for (;;) {
        sum = 0u; cnt = 0u; mine = 0u;
#pragma unroll
        for (unsigned j = 0; j < 16; ++j) { const unsigned c = xb_ld(&bar[XB_XCNT(j)]); sum += c; cnt += (c > 0u) ? 1u : 0u; mine = (j == x) ? c : mine; }
        if (sum == G) break;
        __builtin_amdgcn_s_sleep(1);
        if ((++sp & 255u) == 0u) { if (xb_ld(&bar[XB_TMO])) break; if (sp > XB_SPIN_CAP) { atomicAdd(&bar[XB_TMO], 1u); break; } }
    }
    nloc = mine > 0u ? mine : 1u; nx = cnt > 0u ? cnt : 1u;
}
__device__ __forceinline__ void xcd_barrier(const XcdBarrier& b, bool t0) {
    asm volatile("s_waitcnt vmcnt(0)" ::: "memory");
    __syncthreads();
    if (t0) {
        unsigned* bar = b.bar;
        __builtin_amdgcn_s_waitcnt(0);
        unsigned nloc = b.st[0], nx = b.st[1];
        if (nloc == 0u) { xcd_barrier_complete(bar, b.x, nloc, nx); b.st[0] = nloc; b.st[1] = nx; }
        const unsigned old = xb_add(&bar[XB_XSUB(b.x)], 1u);
        const unsigned gen = old / nloc;
        if (old + 1u == (gen + 1u) * nloc) {
            __builtin_amdgcn_fence(__ATOMIC_RELEASE, "agent");
            asm volatile("s_waitcnt vmcnt(0)" ::: "memory");
            const unsigned og = xb_add(&bar[XB_TOP], 1u);
            const unsigned tg = og / nx;
            if (og + 1u == (tg + 1u) * nx) xb_add(&bar[XB_TOPGEN], 1u);
            else XB_SPIN(xb_ld(&bar[XB_TOPGEN]) == tg, bar);
            __builtin_amdgcn_fence(__ATOMIC_ACQUIRE, "agent");
            xb_add(&bar[XB_XGEN(b.x)], 1u);
            asm volatile("s_waitcnt vmcnt(0)" ::: "memory");
        } else {
            XB_SPIN(xb_ld(&bar[XB_XGEN(b.x)]) == gen, bar);
            __builtin_amdgcn_fence(__ATOMIC_ACQUIRE, "agent");
            asm volatile("s_waitcnt vmcnt(0)" ::: "memory");
        }
    }
    __syncthreads();
}

struct Args {
    const float* in[30];
    float* out; unsigned char* ws;
    int ph_lo, ph_hi;
};
typedef const __attribute__((address_space(4))) Args* KA;
enum { I_X = 0, I_MIXNORM_E, I_WIN, I_GMNORM, I_GMWS, I_GMBS, I_LQ1, I_LK1, I_LQ2, I_LK2, I_SUBLN, I_WOUT, I_FFNNORM, I_FFNGU, I_FFNDN,
       I_MIXNORM_O, I_LAMRE, I_LAMIM, I_LOGDT, I_BRE, I_BIM, I_CRE, I_CIM, I_S5D, I_GLUW, I_MOENORM, I_ROUTER, I_EGU, I_EDN, I_FINALNORM };

__device__ __forceinline__ float row_load_rstd(const float* xrow, int lane, f32x4 (&v)[8]) {
    const f32x4* xr = (const f32x4*)xrow + lane; float s = 0.f;
#pragma unroll
    for (int j = 0; j < 8; ++j) { v[j] = xr[64 * j]; s += (v[j].x * v[j].x + v[j].y * v[j].y) + (v[j].z * v[j].z + v[j].w * v[j].w); }
    return rsqrtf(wave_sum(s) * (1.f / DM) + EPS);
}
__device__ __forceinline__ void rmsnorm_rows_bf16(const float* X, const float* gain, bf16_t* O, int gw, int NGW, int lane) {
    f32x4 gv[8];
#pragma unroll
    for (int j = 0; j < 8; ++j) gv[j] = ((const f32x4*)gain)[lane + 64 * j];
    for (int m = gw; m < M; m += NGW) {
        f32x4 v[8]; const float rstd = row_load_rstd(X + (size_t)m * DM, lane, v);
        u32x2* o = (u32x2*)(O + (size_t)m * DM) + lane;
#pragma unroll
        for (int j = 0; j < 8; ++j) { u32x2 w; w.x = pk2(v[j].x * rstd * gv[j].x, v[j].y * rstd * gv[j].y); w.y = pk2(v[j].z * rstd * gv[j].z, v[j].w * rstd * gv[j].w); o[64 * j] = w; }
    }
}

__device__ __forceinline__ void p0_transpose_item(const float* W, int K, int N, bf16_t* WT, int F  , LAS float* scr, int item, int lane, const float* gain = nullptr  ) {
    const int nblk = N / 32, kb = item / nblk, nb = item % nblk, k0 = 64 * kb, n0 = 32 * nb;
    int d0 = n0;
    if (F) { const int j = (n0 < F) ? n0 : n0 - F; d0 = (j >> 7) * 256 + (j & 127) + ((n0 < F) ? 0 : 128); }
    const int c = lane & 7;
    f32x4 ga = (f32x4){1.f, 1.f, 1.f, 1.f}, gb = ga;
    if (gain) { ga = *(const f32x4*)(gain + k0 + 8 * c); gb = *(const f32x4*)(gain + k0 + 8 * c + 4); }
    { float tv[32]; const float* wp = W + (size_t)(k0 + (lane >> 5)) * N + n0 + (lane & 31);
#pragma unroll
      for (int i = 0; i < 32; ++i) tv[i] = __builtin_nontemporal_load(wp + (size_t)(2 * i) * N);
#pragma unroll
      for (int i = 0; i < 32; ++i) scr[(2 * i + (lane >> 5)) * 33 + (lane & 31)] = tv[i]; }
    asm volatile("s_waitcnt lgkmcnt(0)" ::: "memory");
#pragma unroll
    for (int j = 0; j < 4; ++j) { const int n = (lane >> 3) + 8 * j; const LAS float* s = scr + (8 * c) * 33 + n;
        u32x4 o; o.x = pk2(s[0 * 33] * ga[0], s[1 * 33] * ga[1]); o.y = pk2(s[2 * 33] * ga[2], s[3 * 33] * ga[3]); o.z = pk2(s[4 * 33] * gb[0], s[5 * 33] * gb[1]); o.w = pk2(s[6 * 33] * gb[2], s[7 * 33] * gb[3]);
        *(u32x4*)(WT + (size_t)(d0 + n) * K + k0 + 8 * c) = o; }
    asm volatile("s_waitcnt lgkmcnt(0)" ::: "memory");
}

__device__ __forceinline__ void p0_transpose_item8(const float* W, int K, int N, unsigned char* WT, int F, float scale, LAS float* scr, int item, int lane) {
    const int nblk = N / 32, kb = item / nblk, nb = item % nblk, k0 = 128 * kb, n0 = 32 * nb;
    int d0 = n0;
    if (F) { const int j = (n0 < F) ? n0 : n0 - F; d0 = (j >> 7) * 256 + (j & 127) + ((n0 < F) ? 0 : 128); }
    { float tv[64]; const float* wp = W + (size_t)(k0 + (lane >> 5)) * N + n0 + (lane & 31);
#pragma unroll
      for (int i = 0; i < 64; ++i) tv[i] = __builtin_nontemporal_load(wp + (size_t)(2 * i) * N);
#pragma unroll
      for (int i = 0; i < 64; ++i) scr[(2 * i + (lane >> 5)) * 33 + (lane & 31)] = tv[i]; }
    asm volatile("s_waitcnt lgkmcnt(0)" ::: "memory");
    const int c = lane & 7;
#pragma unroll
    for (int j = 0; j < 4; ++j) { const int n = (lane >> 3) + 8 * j; const LAS float* sp = scr + (16 * c) * 33 + n;
        u32x4 o;
        o.x = pk4_fp8(sp[0 * 33] * scale, sp[1 * 33] * scale, sp[2 * 33] * scale, sp[3 * 33] * scale); o.y = pk4_fp8(sp[4 * 33] * scale, sp[5 * 33] * scale, sp[6 * 33] * scale, sp[7 * 33] * scale);
        o.z = pk4_fp8(sp[8 * 33] * scale, sp[9 * 33] * scale, sp[10 * 33] * scale, sp[11 * 33] * scale); o.w = pk4_fp8(sp[12 * 33] * scale, sp[13 * 33] * scale, sp[14 * 33] * scale, sp[15 * 33] * scale);
        *(u32x4*)(WT + (size_t)(d0 + n) * K + k0 + 16 * c) = o; }
    asm volatile("s_waitcnt lgkmcnt(0)" ::: "memory");
}

__device__ __forceinline__ void p0_transpose_item6(const float* W, int K, int N, unsigned char* WT, int F, LAS float* scr, int item, int lane) {
    const int nblk = N / 32, kb = item / nblk, nb = item % nblk, k0 = 128 * kb, n0 = 32 * nb;
    int d0 = n0;
    if (F) { const int j = (n0 < F) ? n0 : n0 - F; d0 = (j >> 7) * 256 + (j & 127) + ((n0 < F) ? 0 : 128); }
    { float tv[64]; const float* wp = W + (size_t)(k0 + (lane >> 5)) * N + n0 + (lane & 31);
#pragma unroll
      for (int i = 0; i < 64; ++i) tv[i] = __builtin_nontemporal_load(wp + (size_t)(2 * i) * N);
#pragma unroll
      for (int i = 0; i < 64; ++i) scr[(2 * i + (lane >> 5)) * 33 + (lane & 31)] = tv[i]; }
    asm volatile("s_waitcnt lgkmcnt(0)" ::: "memory");
    const int c = lane & 3;
#pragma unroll
    for (int j = 0; j < 2; ++j) { const int n = (lane >> 2) + 16 * j; const LAS float* sp = scr + (32 * c) * 33 + n;
        float x[32];
#pragma unroll
        for (int q = 0; q < 32; ++q) x[q] = sp[q * 33];
        u32x6 pk; unsigned sb; quant_fp6_block(x, pk, sb);
        unsigned char* dst = WT + (size_t)(d0 + n) * K + k0 + 16 * c;
        *(u32x4*)dst = (u32x4){pk[0], pk[1], pk[2], pk[3]}; *(u32x4*)(dst + 64) = (u32x4){pk[4], pk[5], sb, 0u}; }
    asm volatile("s_waitcnt lgkmcnt(0)" ::: "memory");
}

__device__ __forceinline__ void s5_prep_unit(KA a, LAS unsigned char* lds, int g, int nh, int tid) {
    constexpr int PS = 65, KS = 260;
    LAS float* PW = (LAS float*)lds;
    LAS float* BB = PW + 2 * 33 * PS * 2;
    LAS float* CM = BB + 2 * 64 * 16 * 2;
    LAS float* KD = CM + 2 * 16 * PS * 2;
    const float* lam_re = a->in[I_LAMRE]; const float* lam_im = a->in[I_LAMIM]; const float* log_dt = a->in[I_LOGDT];
    const float* b_re = a->in[I_BRE]; const float* b_im = a->in[I_BIM]; const float* c_re = a->in[I_CRE]; const float* c_im = a->in[I_CIM]; const float* dsk = a->in[I_S5D];
    if (tid < 128) {
        const int d = tid >> 6, p = tid & 63;
        const float dt = expf(log_dt[d * S5G + g]);
        const float lr = lam_re[(d * S5G + g) * 64 + p], li = lam_im[(d * S5G + g) * 64 + p];
        const float ar = lr * dt, ai = li * dt;
        for (int j = 0; j <= 32; ++j) {
            const float mag = expf((float)j * ar);
            const double rev = (double)j * (double)ai * 0.15915494309189535; const float fr = (float)(rev - rint(rev));
            PW[((d * 33 + j) * PS + p) * 2 + 0] = mag * __builtin_amdgcn_cosf(fr); PW[((d * 33 + j) * PS + p) * 2 + 1] = mag * __builtin_amdgcn_sinf(fr);
        }
        asm volatile("s_waitcnt lgkmcnt(0)" ::: "memory");
        const float xr = PW[((d * 33 + 1) * PS + p) * 2 + 0] - 1.f, xi = PW[((d * 33 + 1) * PS + p) * 2 + 1];
        const float den = 1.f / (lr * lr + li * li), cr = (xr * lr + xi * li) * den, ci = (xi * lr - xr * li) * den;
        for (int c = 0; c < 16; ++c) { const float br = b_re[((size_t)(d * S5G + g) * 64 + p) * 16 + c], bi = b_im[((size_t)(d * S5G + g) * 64 + p) * 16 + c];
            BB[((d * 64 + p) * 16 + c) * 2 + 0] = cr * br - ci * bi; BB[((d * 64 + p) * 16 + c) * 2 + 1] = cr * bi + ci * br; }
        for (int c = 0; c < 16; ++c) { CM[((d * 16 + c) * PS + p) * 2 + 0] = c_re[((size_t)(d * S5G + g) * 16 + c) * 64 + p]; CM[((d * 16 + c) * PS + p) * 2 + 1] = c_im[((size_t)(d * S5G + g) * 16 + c) * 64 + p]; }
    }
    __syncthreads();
    for (int q = tid; q < 1024; q += 512) {
        const int d = q >> 9, j = (q >> 4) & 31, co = q & 15; float acc[16];
#pragma unroll
        for (int c = 0; c < 16; ++c) acc[c] = 0.f;
        for (int p = 0; p < 64; ++p) {
            const float cr = CM[((d * 16 + co) * PS + p) * 2], ci = CM[((d * 16 + co) * PS + p) * 2 + 1], pr = PW[((d * 33 + j) * PS + p) * 2], pi = PW[((d * 33 + j) * PS + p) * 2 + 1];
            const float wr = cr * pr - ci * pi, wi = cr * pi + ci * pr;
            const LAS float* bb = BB + (d * 64 + p) * 32;
#pragma unroll
            for (int c = 0; c < 16; ++c) acc[c] += wr * bb[2 * c] - wi * bb[2 * c + 1];
        }
#pragma unroll
        for (int c = 0; c < 16; ++c) KD[(d * 32 + j) * KS + co * 16 + c] = acc[c];
    }
    __syncthreads();
    bf16_t* BY = (bf16_t*)(a->ws + WS_S5BY) + (size_t)g * 512 * S5K; bf16_t* BZ = (bf16_t*)(a->ws + WS_S5BZ) + (size_t)g * 256 * 512;
    for (int id = tid; id < 256 * 64; id += 512) {
        const int nl = id >> 6, kc = id & 63, n = 256 * nh + nl, t = n >> 4, co = n & 15, s = kc >> 1, c0 = (kc & 1) * 8; float v[8];
#pragma unroll
        for (int c = 0; c < 8; ++c) { float x = 0.f;
            if (t >= s) x += KD[(0 * 32 + (t - s)) * KS + co * 16 + c0 + c];
            if (s >= t) x += KD[(1 * 32 + (s - t)) * KS + co * 16 + c0 + c];
            if (t == s && c0 + c == co) x += dsk[g * 16 + co];
            v[c] = x; }
        u32x4 w; w.x = pk2(v[0], v[1]); w.y = pk2(v[2], v[3]); w.z = pk2(v[4], v[5]); w.w = pk2(v[6], v[7]);
        *(u32x4*)(BY + (size_t)n * S5K + kc * 8) = w;
    }
    for (int id = tid; id < 256 * 32; id += 512) {
        const int nl = id >> 5, kc = id & 31, n = 256 * nh + nl, t = n >> 4, co = n & 15, d = kc >> 4, p0 = (kc & 15) * 4, e = d ? (32 - t) : (t + 1); float v[8];
#pragma unroll
        for (int q = 0; q < 4; ++q) { const int p = p0 + q; const float cr = CM[((d * 16 + co) * PS + p) * 2], ci = CM[((d * 16 + co) * PS + p) * 2 + 1], pr = PW[((d * 33 + e) * PS + p) * 2], pi = PW[((d * 33 + e) * PS + p) * 2 + 1];
            v[2 * q] = cr * pr - ci * pi; v[2 * q + 1] = -(cr * pi + ci * pr); }
        u32x4 w; w.x = pk2(v[0], v[1]); w.y = pk2(v[2], v[3]); w.z = pk2(v[4], v[5]); w.w = pk2(v[6], v[7]);
        *(u32x4*)(BY + (size_t)n * S5K + 512 + kc * 8) = w;
    }
    for (int id = tid; id < 128 * 64; id += 512) {
        const int nl = id >> 6, kc = id & 63, d = nh, p = nl >> 1, ri = nl & 1, s = kc >> 1, c0 = (kc & 1) * 8, e = d ? s : (31 - s); float v[8];
        const float pr = PW[((d * 33 + e) * PS + p) * 2], pi = PW[((d * 33 + e) * PS + p) * 2 + 1];
#pragma unroll
        for (int c = 0; c < 8; ++c) { const float br = BB[((d * 64 + p) * 16 + c0 + c) * 2], bi = BB[((d * 64 + p) * 16 + c0 + c) * 2 + 1]; v[c] = ri ? (pr * bi + pi * br) : (pr * br - pi * bi); }
        u32x4 w; w.x = pk2(v[0], v[1]); w.y = pk2(v[2], v[3]); w.z = pk2(v[4], v[5]); w.w = pk2(v[6], v[7]);
        *(u32x4*)(BZ + (size_t)(128 * nh + nl) * 512 + kc * 8) = w;
    }
    __syncthreads();
}

__device__ __forceinline__ void gating_phase(KA a, LAS unsigned char* lds, int u0, int ustride, int tid) {
    int lane = tid & 63; asm volatile("" : "+v"(lane)); const int wid = tid >> 6;
    const bf16_t* PROJ = (const bf16_t*)(a->ws + WS_PROJ); bf16_t* MIXED = (bf16_t*)(a->ws + WS_MIXED);
    LAS bf16_t* VT = (LAS bf16_t*)lds;
    LAS bf16_t* OT = (LAS bf16_t*)(lds + 69632);
    const int fr = lane & 15, fq = lane >> 4;
    u32x2 rawv[16];
#define GT_TOK0(u_) ((size_t)((u_) >> 6) * SEQ + (((u_) >> 2) & 15) * 128)
#define GT_LDV(u_) do { const size_t t0_ = GT_TOK0(u_); const int g_ = (u_) & 3; _Pragma("unroll") for (int i = 0; i < 16; ++i) rawv[i] = *(const u32x2*)(PROJ + (t0_ + wid * 16 + i) * MIX_IN + 1024 + g_ * 256 + 4 * lane); } while (0)
    if (u0 < 1024) GT_LDV(u0);
    for (int u = u0; u < 1024; u += ustride) {
        const int g = u & 3; const size_t tok0 = GT_TOK0(u);
        const bf16_t* WSB = (const bf16_t*)(a->ws + WS_GMWS) + g * 128 * 128; const float* gmn = a->in[I_GMNORM] + g * 256; const float* gbs = a->in[I_GMBS] + g * 128;
        { const f32x4 gn = *(const f32x4*)(gmn + 4 * lane);
#pragma unroll
          for (int i = 0; i < 16; ++i) { const int s = wid * 16 + i;
            const u32x2 raw = rawv[i];
            const float v0 = bflo(raw.x), v1 = bfhi(raw.x), v2 = bflo(raw.y), v3 = bfhi(raw.y);
            const float rstd = rsqrtf(wave_sum((v0 * v0 + v1 * v1) + (v2 * v2 + v3 * v3)) * (1.f / 256.f) + EPS);
            const unsigned w0 = pk2(v0 * rstd * gn.x, v1 * rstd * gn.y), w1 = pk2(v2 * rstd * gn.z, v3 * rstd * gn.w);
            VT[(4 * lane + 0) * 136 + s] = (bf16_t)(w0 & 0xffff); VT[(4 * lane + 1) * 136 + s] = (bf16_t)(w0 >> 16);
            VT[(4 * lane + 2) * 136 + s] = (bf16_t)(w1 & 0xffff); VT[(4 * lane + 3) * 136 + s] = (bf16_t)(w1 >> 16); } }
        __syncthreads();
        if (u + ustride < 1024) GT_LDV(u + ustride);
        u32x4 uv[8];
#pragma unroll
        for (int j = 0; j < 8; ++j) { const int idx = tid + 512 * j, t = idx >> 5, ch = idx & 31; uv[j] = *(const u32x4*)(PROJ + (tok0 + t) * MIX_IN + g * 256 + ch * 8); }
        f32x4 acc[2][8];
#pragma unroll
        for (int cb = 0; cb < 2; ++cb)
#pragma unroll
            for (int tb = 0; tb < 8; ++tb) acc[cb][tb] = (f32x4){0.f, 0.f, 0.f, 0.f};
#pragma unroll 2
        for (int ks = 0; ks < 4; ++ks) {
            bf16x8 af[2];
#pragma unroll
            for (int cb = 0; cb < 2; ++cb) af[cb] = *(const LAS bf16x8*)(VT + (32 * wid + 16 * cb + fr) * 136 + 32 * ks + 8 * fq);
#pragma unroll
            for (int tb = 0; tb < 8; ++tb) { const bf16x8 bfm = *(const bf16x8*)(WSB + (16 * tb + fr) * 128 + 32 * ks + 8 * fq);
#pragma unroll
                for (int cb = 0; cb < 2; ++cb) acc[cb][tb] = __builtin_amdgcn_mfma_f32_16x16x32_bf16(af[cb], bfm, acc[cb][tb], 0, 0, 0); }
        }
#pragma unroll
        for (int tb = 0; tb < 8; ++tb) { const int t = 16 * tb + fr; const float bs = gbs[t];
#pragma unroll
            for (int cb = 0; cb < 2; ++cb) { const int c = 32 * wid + 16 * cb + 4 * fq; const f32x4 mx = acc[cb][tb];
                u32x2 w; w.x = pk2(mx[0] + bs, mx[1] + bs); w.y = pk2(mx[2] + bs, mx[3] + bs);
                *(LAS u32x2*)(OT + t * 264 + c) = w; } }
        __syncthreads();
#pragma unroll
        for (int j = 0; j < 8; ++j) { const int idx = tid + 512 * j, t = idx >> 5, ch = idx & 31; const u32x4 mv = *(const LAS u32x4*)(OT + t * 264 + ch * 8); const u32x4 u4 = uv[j]; u32x4 w;
            w.x = pk2(bflo(u4.x) * bflo(mv.x), bfhi(u4.x) * bfhi(mv.x)); w.y = pk2(bflo(u4.y) * bflo(mv.y), bfhi(u4.y) * bfhi(mv.y));
            w.z = pk2(bflo(u4.z) * bflo(mv.z), bfhi(u4.z) * bfhi(mv.z)); w.w = pk2(bflo(u4.w) * bflo(mv.w), bfhi(u4.w) * bfhi(mv.w));
            *(u32x4*)(MIXED + (tok0 + t) * DM + g * 256 + ch * 8) = w; }
        __syncthreads();
    }
#undef GT_LDV
#undef GT_TOK0
}

constexpr int AT_KB = 9216, AT_VB = 20480, AT_K0 = 0, AT_V0 = 2 * AT_KB, AT_SCR = AT_V0 + 2 * AT_VB  , AT_SSQ = AT_SCR + 8 * 256  , AT_Q = AT_SSQ + 8 * 4224  ;
__device__ __forceinline__ int crow(int r, int hi) { return (r & 3) + 8 * (r >> 2) + 4 * hi; }
__device__ __forceinline__ void attn_unit(KA a, LAS unsigned char* lds, int b, int h, int qb, float lam, int tid_in) {
    int tid = tid_in; asm volatile("" : "+v"(tid));
    int lane = tid & 63; asm volatile("" : "+v"(lane));
    const int wid = __builtin_amdgcn_readfirstlane(tid >> 6), r32 = lane & 31, hi = lane >> 5;
    const bf16_t* PROJ = (const bf16_t*)(a->ws + WS_PROJ); bf16_t* MIXED = (bf16_t*)(a->ws + WS_MIXED); float* O0S = (float*)(a->ws + WS_O0);
    const size_t tokb = (size_t)b * SEQ; const int q0 = qb * 256 + wid * 32;
    const float sl2 = exp2f(-(float)(h + 1)) * 1.4426950408889634f;
    LAS float* scr = (LAS float*)(lds + AT_SCR) + wid * 64;
    LAS float* ssq = (LAS float*)(lds + AT_SSQ) + wid * 1056;
    const int krow = tid >> 3, kch = tid & 7;
    const int vrow0 = tid >> 4, vch = tid & 15;
    const int tr_q = (lane & 15) >> 2, tr_p = lane & 3, tr_blk = (lane >> 4) & 1;
    const int vrd = (4 * hi + tr_q) * 320 + (16 * tr_blk + 4 * tr_p) * 2;
    const int t0 = 4 * qb;
    for (int mp = 0; mp < 2; ++mp) {
        const bf16_t* Kg = PROJ + tokb * MIX_IN + 3072 + h * 128 + mp * 64;
        const bf16_t* Vg = PROJ + tokb * MIX_IN + 4096 + h * 128;
        LAS unsigned char* QB = lds + AT_Q + wid * 4608 + r32 * 144 + hi * 16;
#pragma unroll
        for (int d0 = 0; d0 < 4; ++d0) *(LAS bf16x8*)(QB + d0 * 32) = *(const bf16x8*)(PROJ + (tokb + q0 + r32) * MIX_IN + 2048 + h * 128 + mp * 64 + d0 * 16 + hi * 8);
        f32x16 o[4];
#pragma unroll
        for (int e = 0; e < 4; ++e)
#pragma unroll
            for (int r = 0; r < 16; ++r) o[e][r] = 0.f;
        float mref = -1e30f, lsum = 0.f;
        u32x4 kreg, vreg0, vreg1;
#define AT_LDK(i_) (*(const u32x4*)(Kg + (size_t)((((t0 + (i_)) & 31) * 64) + krow) * MIX_IN + kch * 8))
#define AT_LDV(i_, ro) (*(const u32x4*)(Vg + (size_t)((((t0 + (i_)) & 31) * 64) + vrow0 + (ro)) * MIX_IN + vch * 8))
#define AT_STK(buf, v) (*(LAS u32x4*)(lds + AT_K0 + (buf) * AT_KB + krow * 144 + kch * 16) = (v))
#define AT_STV(buf, ro, v) (*(LAS u32x4*)(lds + AT_V0 + (buf) * AT_VB + (vrow0 + (ro)) * 320 + vch * 16) = (v))
#define AT_QK(D0, D1, buf) do { const LAS unsigned char* KB_ = lds + AT_K0 + (buf) * AT_KB; \
            _Pragma("unroll") for (int r_ = 0; r_ < 16; ++r_) { D0[r_] = 0.f; D1[r_] = 0.f; } \
            _Pragma("unroll") for (int d0 = 0; d0 < 4; ++d0) { \
                const bf16x8 ka = *(const LAS bf16x8*)(KB_ + r32 * 144 + d0 * 32 + hi * 16), kb = *(const LAS bf16x8*)(KB_ + (32 + r32) * 144 + d0 * 32 + hi * 16); \
                const bf16x8 qf = *(const LAS bf16x8*)(QB + d0 * 32); \
                D0 = __builtin_amdgcn_mfma_f32_32x32x16_bf16(ka, qf, D0, 0, 0, 0); D1 = __builtin_amdgcn_mfma_f32_32x32x16_bf16(kb, qf, D1, 0, 0, 0); } } while (0)
        { kreg = AT_LDK(0); vreg0 = AT_LDV(0, 0); vreg1 = AT_LDV(0, 32); const u32x4 k1 = AT_LDK(1);
          AT_STK(0, kreg); AT_STV(0, 0, vreg0); AT_STV(0, 32, vreg1); AT_STK(1, k1); }
        __syncthreads();
        f32x16 p0, p1;
        AT_QK(p0, p1, 0);
        __syncthreads();
#define AT_STEP(HAS1, HAS2) do { \
            const int k0 = ((t0 + it) & 31) * 64; \
            if (HAS2) kreg = AT_LDK(it + 2); \
            if (HAS1) { vreg0 = AT_LDV(it + 1, 0); vreg1 = AT_LDV(it + 1, 32); } \
            f32x16 n0, n1; \
            if (HAS1) AT_QK(n0, n1, (it + 1) & 1); \
            __builtin_amdgcn_sched_barrier(0); \
            const LAS unsigned char* VB = lds + AT_V0 + (it & 1) * AT_VB; \
            float xf = (float)(q0 + r32 - k0 - 4 * hi); asm volatile("" : "+v"(xf));   \
            float rm = -1e30f; \
            _Pragma("unroll") for (int r = 0; r < 16; ++r) { const float dd = xf - (float)((r & 3) + 8 * (r >> 2)); \
                p0[r] = p0[r] - sl2 * fabsf(dd); p1[r] = p1[r] - sl2 * fabsf(dd - 32.f); rm = fmaxf(rm, fmaxf(p0[r], p1[r])); } \
            rm = half_max(rm); \
            if (__any(rm > mref + 8.f)) { \
                const float mn = fmaxf(mref, rm), al = __builtin_amdgcn_exp2f(mref - mn); mref = mn; lsum *= al; \
                if (hi == 0) scr[r32] = al; \
                asm volatile("s_waitcnt lgkmcnt(0)" ::: "memory"); \
                _Pragma("unroll") for (int r = 0; r < 16; ++r) { const float f = scr[crow(r, hi)]; \
                    _Pragma("unroll") for (int e = 0; e < 4; ++e) o[e][r] *= f; } \
            } \
            float ps = 0.f; \
            _Pragma("unroll") for (int r = 0; r < 16; ++r) { p0[r] = __builtin_amdgcn_exp2f(p0[r] - mref); p1[r] = __builtin_amdgcn_exp2f(p1[r] - mref); ps += p0[r]; ps += p1[r]; }   \
            lsum += ps; \
            bf16x8 pa[4]; \
            { u32x4 w; \
              w.x = pk2(p0[0], p0[1]); w.y = pk2(p0[2], p0[3]); w.z = pk2(p0[4], p0[5]); w.w = pk2(p0[6], p0[7]); pa[0] = __builtin_bit_cast(bf16x8, w); \
              w.x = pk2(p0[8], p0[9]); w.y = pk2(p0[10], p0[11]); w.z = pk2(p0[12], p0[13]); w.w = pk2(p0[14], p0[15]); pa[1] = __builtin_bit_cast(bf16x8, w); \
              w.x = pk2(p1[0], p1[1]); w.y = pk2(p1[2], p1[3]); w.z = pk2(p1[4], p1[5]); w.w = pk2(p1[6], p1[7]); pa[2] = __builtin_bit_cast(bf16x8, w); \
              w.x = pk2(p1[8], p1[9]); w.y = pk2(p1[10], p1[11]); w.z = pk2(p1[12], p1[13]); w.w = pk2(p1[14], p1[15]); pa[3] = __builtin_bit_cast(bf16x8, w); } \
            __builtin_amdgcn_sched_barrier(0); \
            _Pragma("unroll") for (int ks = 0; ks < 4; ++ks) { \
                _Pragma("unroll") for (int e = 0; e < 4; ++e) { \
                    const LAS unsigned char* vp = VB + vrd + ks * 16 * 320 + e * 64; \
                    const s16x4 lo = __builtin_amdgcn_ds_read_tr16_b64_v4i16((LAS s16x4*)(vp)), hh = __builtin_amdgcn_ds_read_tr16_b64_v4i16((LAS s16x4*)(vp + 8 * 320)); \
                    const bf16x8 vf = (bf16x8){lo[0], lo[1], lo[2], lo[3], hh[0], hh[1], hh[2], hh[3]}; \
                    o[e] = __builtin_amdgcn_mfma_f32_32x32x16_bf16(pa[ks], vf, o[e], 0, 0, 0); } \
                __builtin_amdgcn_sched_barrier(0); } \
            if (HAS2) AT_STK(it & 1, kreg); \
            if (HAS1) { AT_STV((it + 1) & 1, 0, vreg0); AT_STV((it + 1) & 1, 32, vreg1); } \
            __syncthreads(); \
            if (HAS1) { p0 = n0; p1 = n1; } } while (0)
        int it = 0;
        for (; it < 30; ++it) AT_STEP(true, true);
        AT_STEP(true, false); ++it;
        AT_STEP(false, false);
#undef AT_STEP
#undef AT_QK
#undef AT_LDK
#undef AT_LDV
#undef AT_STK
#undef AT_STV
        int r32e = r32, hie = hi; asm volatile("" : "+v"(r32e), "+v"(hie));
        lsum = half_sum(lsum);
        if (hie == 0) scr[r32e] = 1.f / lsum;
        asm volatile("s_waitcnt lgkmcnt(0)" ::: "memory");
#pragma unroll
        for (int r = 0; r < 16; ++r) { const float l_ = scr[crow(r, hie)];
#pragma unroll
            for (int e = 0; e < 4; ++e) o[e][r] *= l_; }
        int tide = tid; asm volatile("" : "+v"(tide));
        u32x4* ob = (u32x4*)O0S + (size_t)((b * 8 + h) * 8 + qb) * (8 * 512) + tide;
        if (mp == 0) {
#pragma unroll
            for (int e = 0; e < 4; ++e) {
#pragma unroll
                for (int h2 = 0; h2 < 2; ++h2) { u32x4 w; w.x = pk2(o[e][8 * h2 + 0], o[e][8 * h2 + 1]); w.y = pk2(o[e][8 * h2 + 2], o[e][8 * h2 + 3]); w.z = pk2(o[e][8 * h2 + 4], o[e][8 * h2 + 5]); w.w = pk2(o[e][8 * h2 + 6], o[e][8 * h2 + 7]);
                    ob[(2 * e + h2) * 512] = w; }
                __builtin_amdgcn_sched_barrier(0); }
        } else {
            float ss[16];
#pragma unroll
            for (int h2 = 0; h2 < 2; ++h2) {
                u32x4 ov[4];
#pragma unroll
                for (int e = 0; e < 4; ++e) ov[e] = ob[(2 * e + h2) * 512];
                __builtin_amdgcn_sched_barrier(0);
#pragma unroll
                for (int rr = 0; rr < 8; ++rr) { float s2 = 0.f;
#pragma unroll
                    for (int e = 0; e < 4; ++e) { const unsigned dw = ov[e][rr >> 1]; const float o0 = (rr & 1) ? bfhi(dw) : bflo(dw);
                        const float d = o0 - lam * o[e][8 * h2 + rr]; o[e][8 * h2 + rr] = d; s2 += d * d; }
                    ss[8 * h2 + rr] = s2; }
                __builtin_amdgcn_sched_barrier(0);
            }
#pragma unroll
            for (int r = 0; r < 16; ++r) ssq[crow(r, hie) * 33 + r32e] = ss[r];
            asm volatile("s_waitcnt lgkmcnt(0)" ::: "memory");
            { float tot = 0.f;
#pragma unroll
              for (int j = 0; j < 32; ++j) tot += ssq[r32e * 33 + j];
              if (hie == 0) scr[r32e] = rsqrtf(tot * (1.f / 128.f) + EPS) * 0.8f; }
            asm volatile("s_waitcnt lgkmcnt(0)" ::: "memory");
            const float* sg = a->in[I_SUBLN];
            float gsub[4];
#pragma unroll
            for (int e = 0; e < 4; ++e) gsub[e] = sg[32 * e + r32e];
            LAS unsigned char* tb = lds + wid * 4096;
            const int lane_e = r32e + 32 * hie;
#pragma unroll
            for (int hf = 0; hf < 2; ++hf) {
#pragma unroll
                for (int r = 0; r < 16; ++r) { const float rs = scr[crow(r, hie)];
#pragma unroll
                    for (int e2 = 0; e2 < 2; ++e2) *(LAS unsigned short*)(tb + crow(r, hie) * 128 + (32 * e2 + r32e) * 2) = (unsigned short)(pk2(o[2 * hf + e2][r] * rs * gsub[2 * hf + e2], 0.f) & 0xffff); }
                asm volatile("s_waitcnt lgkmcnt(0)" ::: "memory");
#pragma unroll
                for (int k = 0; k < 4; ++k) { const int idx = k * 64 + lane_e, row = idx >> 3, ch = idx & 7;
                    const u32x4 v = *(const LAS u32x4*)(tb + row * 128 + ch * 16);
                    *(u32x4*)(MIXED + (tokb + q0 + row) * DM + 1024 + h * 128 + hf * 64 + ch * 8) = v; }
                asm volatile("s_waitcnt lgkmcnt(0)" ::: "memory");
            }
        }
        __syncthreads();
    }
}

constexpr int NPHASE = 17;
__global__ void __launch_bounds__(512, 2) fwd_kernel(Args a_unused) {
    extern __shared__ __attribute__((aligned(16))) unsigned char lds_raw[];
    const KA a0 = (KA)__builtin_amdgcn_kernarg_segment_ptr(); KA a = a0;
    LAS unsigned char* lds = (LAS unsigned char*)lds_raw;
    const int wave = __builtin_amdgcn_readfirstlane((int)threadIdx.x >> 6);
    const int lane = lane_id_v(), tid = wave * 64 + lane;
    const int G = gridDim.x, bx = blockIdx.x;
    const int vcu = (G % 8 == 0) ? (bx % 8) * (G / 8) + bx / 8 : bx;
    const int gw = vcu * 8 + wave, NGW = G * 8;
    unsigned* ctl = (unsigned*)(a->ws + WS_CTL);
    volatile LAS unsigned* MISC = (volatile LAS unsigned*)(lds + LDSCTL_OFF);
    for (int u = tid; u < (LDS_BYTES - LDSCTL_OFF) / 4; u += 512) ((LAS unsigned*)(lds + LDSCTL_OFF))[u] = 0u;
    __syncthreads();
    XcdBarrier bar; bar.bar = ctl + CW_BAR; bar.x = 0; bar.st = nullptr;
    if (!MK_MULTI) bar = xcd_barrier_post(ctl + CW_BAR, MISC + 8, tid == 0);
    const int lo = a->ph_lo, hi = a->ph_hi;
#ifndef PH_MASK
#define PH_MASK 0x1ffff
#endif
#define IN(k) (((PH_MASK >> (k)) & 1) && lo <= (k) && (k) < hi)
#define PH_BEGIN KA a = a0; asm volatile("" : "+s"(a)); const int lane = lane_id_v(), tid = wave * 64 + lane; (void)tid; (void)lane;
#ifndef DUP_MASK
#define DUP_MASK 0
#endif
#define REP(k) for (int rep_ = 0; rep_ < 1 + ((DUP_MASK >> (k)) & 1); ++rep_)
#define SEAM(k) do { if (!MK_MULTI && IN((k) + 1)) xcd_barrier(bar, wave == 0 && lane_id_v() == 0); } while (0)

    bf16_t* HN = (bf16_t*)(a->ws + WS_HN);
    float* H = a->out;

    if (IN(0)) { PH_BEGIN REP(0) {
        for (int u = bx; u < 256; u += G) s5_prep_unit(a, lds, u >> 1, u & 1, tid);
        LAS float* scr = (LAS float*)(lds + wave * 16896);
        constexpr int I0 = 32 * 160, I1 = 32 * 64, I2 = 32 * 352, I3 = 44 * 64, I4 = 16 * 128, I5 = 16 * 448, I6 = 56 * 64;
        constexpr int NITEMS = I0 + I1 + I2 + I3 + I4 + 8 * I5 + 8 * I6;
        for (int it = gw; it < NITEMS; it += NGW) {
            int r = it;
            if (r < I0) { p0_transpose_item(a->in[I_WIN], DM, MIX_IN, (bf16_t*)(a->ws + WS_WIN), 0, scr, r, lane); continue; } r -= I0;
            if (r < I1) { p0_transpose_item(a->in[I_WOUT], DM, DM, (bf16_t*)(a->ws + WS_WOUT), 0, scr, r, lane); continue; } r -= I1;
            if (r < I2) { p0_transpose_item(a->in[I_FFNGU], DM, 2 * DFF, (bf16_t*)(a->ws + WS_WGU), DFF, scr, r, lane, a->in[I_FFNNORM]); continue; } r -= I2;
            if (r < I3) { p0_transpose_item8(a->in[I_FFNDN], DFF, DM, a->ws + WS_WDN, 0, W8_DN_SCALE, scr, r, lane); continue; } r -= I3;
            if (r < I4) { p0_transpose_item8(a->in[I_GLUW], DM, 2 * DM, a->ws + WS_WGLU, DM, W8_GU_SCALE, scr, r, lane); continue; } r -= I4;
            if (r < 8 * I5) { const int e = r / I5; p0_transpose_item6(a->in[I_EGU] + (size_t)e * DM * 2 * DFE, DM, 2 * DFE, a->ws + WS_WEGU + (size_t)e * 2 * DFE * DM, DFE, scr, r % I5, lane); continue; } r -= 8 * I5;
            { const int e = r / I6; p0_transpose_item8(a->in[I_EDN] + (size_t)e * DFE * DM, DFE, DM, a->ws + WS_WEDN + (size_t)e * DM * DFE, 0, W8_DN_SCALE, scr, r % I6, lane); }
        }
        { const float* src = a->in[I_GMWS]; bf16_t* dst = (bf16_t*)(a->ws + WS_GMWS);
          for (int i = bx * 512 + tid; i < 4 * 128 * 128 / 2; i += G * 512) ((unsigned*)dst)[i] = pk2(src[2 * i], src[2 * i + 1]); }
        rmsnorm_rows_bf16(a->in[I_X], a->in[I_MIXNORM_E], HN, gw, NGW, lane);
        }
        SEAM(0);
    }
    if (IN(1)) { PH_BEGIN REP(1) {
        pg8::Gemm g{HN, (const bf16_t*)(a->ws + WS_WIN), DM, DM, DM}; pg8::GridOrder S; S.init(M / 256, MIX_IN / 256, G, bx);
        pg8::EpiProj E{(bf16_t*)(a->ws + WS_PROJ)};
        pg8::gemm_phase(lds, g, S, E, wave);
        }
        SEAM(1);
    }
    if (IN(2)) { PH_BEGIN
        float lam;
        { const float sa = wave_sum(a->in[I_LQ1][lane] * a->in[I_LK1][lane]), sb = wave_sum(a->in[I_LQ2][lane] * a->in[I_LK2][lane]); lam = expf(sa) - expf(sb) + 0.2f; }
        for (int u = vcu; u < 1024; u += G) { const int bh = u >> 3; attn_unit(a, lds, bh >> 3, bh & 7, u & 7, lam, wave * 64 + lane_id_v()); }
    }
    if (IN(2)) { PH_BEGIN
        gating_phase(a, lds, vcu, G, tid);
        SEAM(2);
    }
#if (DUP_MASK >> 2) & 1
    if (IN(2)) { PH_BEGIN
        float lam;
        { const float sa = wave_sum(a->in[I_LQ1][lane] * a->in[I_LK1][lane]), sb = wave_sum(a->in[I_LQ2][lane] * a->in[I_LK2][lane]); lam = expf(sa) - expf(sb) + 0.2f; }
        for (int u = vcu; u < 1024; u += G) { const int bh = u >> 3; attn_unit(a, lds, bh >> 3, bh & 7, u & 7, lam, tid); }
        SEAM(2);
    }
#endif
#if (DUP_MASK >> 17) & 1
    if (IN(2)) { PH_BEGIN
        gating_phase(a, lds, vcu, G, tid);
        SEAM(2);
    }
#endif
    if (IN(3)) { PH_BEGIN REP(3) {
        pg8::Gemm g{(const bf16_t*)(a->ws + WS_MIXED), (const bf16_t*)(a->ws + WS_WOUT), DM, DM, DM}; pg8::GridOrder S; S.init(M / 256, DM / 256, G, bx);
        pg8::EpiResSq E{a->in[I_X], a->ws};
        pg8::gemm_phase(lds, g, S, E, wave);
        }
        SEAM(3);
    }
    if (IN(5)) { PH_BEGIN REP(5) {
        pg8::Gemm g{HN, (const bf16_t*)(a->ws + WS_WGU), DM, DM, DM}; pg8::GridOrder S; S.init(M / 256, 2 * DFF / 256, G, bx);
        int pmA = -1, pmB = -1; bool two_ok = true;
        { pg8::Unit uu; for (int i = 0; S.next(i, uu); ++i) { if (pmA < 0) pmA = uu.pm; else if (uu.pm != pmA) { if (pmB < 0) pmB = uu.pm; else if (uu.pm != pmB) two_ok = false; } } if (pmB < 0) pmB = pmA; }
        LAS float* rst = (LAS float*)(lds + 131072);
        { const int tb_ = tid >> 8, rw_ = tid & 255; const int pm_ = tb_ ? pmB : pmA;
          if (pm_ >= 0) { const f32x4* sp = (const f32x4*)((const float*)(a->ws + WS_SL) + (size_t)(pm_ * 256 + rw_) * 32); float t_ = 0.f;
#pragma unroll
            for (int k = 0; k < 8; ++k) { const f32x4 q4 = sp[k]; t_ += (q4[0] + q4[1]) + (q4[2] + q4[3]); }
            rst[tid] = two_ok ? rsqrtf(t_ * (1.f / DM) + EPS) : __builtin_nanf(""); } }
        __syncthreads();
        pg8::EpiSwiGLUr8<1 << 20> E{a->ws + WS_ACT, DFF, rst, pmA, A8_FFN_SCALE};
        pg8::gemm_phase(lds, g, S, E, wave);
        }
        SEAM(5);
    }
    if (IN(6)) { PH_BEGIN
        pg8::Gemm g{(const bf16_t*)(a->ws + WS_ACT), (const bf16_t*)(a->ws + WS_WDN), DFF / 2, DFF / 2, DFF / 2}; pg8::GridOrder S; S.init(M / 256, DM / 256, G, bx, 1);
#if (DUP_MASK >> 6) & 1
        { pg8::EpiResF32 E2{H, (float*)(a->ws + WS_XP)}; pg8::gemm_phase(lds, g, S, E2, wave); }
#endif
        pg8::EpiResBf E{HN, 1.f / (W8_DN_SCALE * A8_FFN_SCALE)};
        pg8::gemm_phase<1>(lds, g, S, E, wave);
        SEAM(6);
    }
    if (IN(7)) { PH_BEGIN REP(7) {
        bf16_t* UA = (bf16_t*)(a->ws + WS_UA);
        LAS float* gl = (LAS float*)lds;
        for (int i = tid; i < DM / 4; i += 512) ((LAS f32x4*)gl)[i] = ((const f32x4*)a->in[I_MIXNORM_O])[i];
        __syncthreads();
        const int gq = lane >> 3, t = (lane >> 1) & 3, hf = lane & 1;
        for (int m0 = gw * 4; m0 < M; m0 += NGW * 4) {
            const int m = m0 + t;
            const bf16_t* xr = HN + (size_t)m * DM + gq * 16 + hf * 8;
            u32x4 x[16]; float sq_ = 0.f;
#pragma unroll
            for (int j = 0; j < 16; ++j) x[j] = *(const u32x4*)(xr + j * 128);
#pragma unroll
            for (int j = 0; j < 16; ++j) { const u32x4 p = x[j];
                const float a0 = bflo(p.x), a1 = bfhi(p.x), a2 = bflo(p.y), a3 = bfhi(p.y), a4 = bflo(p.z), a5 = bfhi(p.z), a6 = bflo(p.w), a7 = bfhi(p.w);
                sq_ += ((a0 * a0 + a1 * a1) + (a2 * a2 + a3 * a3)) + ((a4 * a4 + a5 * a5) + (a6 * a6 + a7 * a7)); }
            sq_ += swz_xor<1>(sq_); sq_ += swz_xor<8>(sq_); sq_ += swz_xor<16>(sq_); sq_ = half_sum(sq_);
            const float rstd = rsqrtf(sq_ * (1.f / DM) + EPS);
            const int b = m >> 11, sqn = m & 2047, ch = sqn >> 5, sp = sqn & 31;
            bf16_t* up = UA + ((size_t)gq * 1024 + b * 64 + ch) * S5K + sp * 16 + hf * 8;
            unsigned go_ = (unsigned)(gq * 16 + hf * 8) * 4u; asm volatile("" : "+v"(go_));
            const LAS unsigned char* glb = (const LAS unsigned char*)gl + go_;
#pragma unroll
            for (int j = 0; j < 16; ++j) { const u32x4 p = x[j]; const f32x4 g0 = *(const LAS f32x4*)(glb + j * 512), g1 = *(const LAS f32x4*)(glb + j * 512 + 16);
                u32x4 w; w.x = pk2(bflo(p.x) * rstd * g0.x, bfhi(p.x) * rstd * g0.y); w.y = pk2(bflo(p.y) * rstd * g0.z, bfhi(p.y) * rstd * g0.w);
                w.z = pk2(bflo(p.z) * rstd * g1.x, bfhi(p.z) * rstd * g1.y); w.w = pk2(bflo(p.w) * rstd * g1.z, bfhi(p.w) * rstd * g1.w);
                *(u32x4*)(up + (size_t)(8 * j) * 1024 * S5K) = w;
                if ((j & 3) == 3) __builtin_amdgcn_sched_barrier(0); }
        }
        }
        __syncthreads();
        SEAM(7);
    }
    if (IN(8)) { PH_BEGIN REP(8) {
        pg8::Gemm g{(const bf16_t*)(a->ws + WS_UA), (const bf16_t*)(a->ws + WS_S5BZ), S5K, 512, 512}; pg8::BatchOrder<4, 1> S; S.init(S5G, G, bx);
        pg8::EpiZ E{(bf16_t*)(a->ws + WS_Z)};
        pg8::gemm_phase(lds, g, S, E, wave);
        }
        SEAM(8);
    }
    if (IN(9)) { PH_BEGIN REP(9) {
        const bf16_t* Z = (const bf16_t*)(a->ws + WS_Z); bf16_t* UA = (bf16_t*)(a->ws + WS_UA);
        for (int id = bx * 512 + tid; id < S5G * NB * 128; id += G * 512) {
            const int p = id & 63, d = (id >> 6) & 1, b = (id >> 7) & 15, g = id >> 11;
            const float dt = expf(a->in[I_LOGDT][d * S5G + g]);
            const float ar = a->in[I_LAMRE][(d * S5G + g) * 64 + p] * dt, ai = a->in[I_LAMIM][(d * S5G + g) * 64 + p] * dt;
            const float mag = expf(32.f * ar); const double rev = 32.0 * (double)ai * 0.15915494309189535; const float fr = (float)(rev - rint(rev));
            const float lr = mag * __builtin_amdgcn_cosf(fr), li = mag * __builtin_amdgcn_sinf(fr);
            float sr = 0.f, si = 0.f;
            const size_t row0 = (size_t)g * 1024 + b * 64;
            const bf16_t* zp = Z + (row0 + (d ? 63 : 0)) * 256 + d * 128 + 2 * p; bf16_t* up = UA + (row0 + (d ? 63 : 0)) * S5K + 512 + d * 128 + 2 * p;
            const long zstep = d ? -256 : 256, ustep = d ? -(long)S5K : (long)S5K;
#pragma unroll 1
            for (int hb = 0; hb < 4; ++hb) {
                f32x2 zz[16];
#pragma unroll
                for (int i = 0; i < 16; ++i) { const unsigned zw = *(const unsigned*)(zp + (hb * 16 + i) * zstep); zz[i] = (f32x2){bflo(zw), bfhi(zw)}; }
#pragma unroll
                for (int i = 0; i < 16; ++i) {
                    *(unsigned*)(up + (hb * 16 + i) * ustep) = pk2(sr, si);
                    const float nr = lr * sr - li * si + zz[i].x, ni = lr * si + li * sr + zz[i].y; sr = nr; si = ni; }
            }
        }
        }
        SEAM(9);
    }
    if (IN(10)) { PH_BEGIN REP(10) {
        pg8::Gemm g{(const bf16_t*)(a->ws + WS_UA), (const bf16_t*)(a->ws + WS_S5BY), S5K, S5K, S5K}; pg8::BatchOrder<4, 2> S; S.init(S5G, G, bx);
        pg8::EpiS5Y E{a->ws + WS_YG};
        pg8::gemm_phase(lds, g, S, E, wave);
        }
        SEAM(10);
    }
    if (IN(11)) { PH_BEGIN
        pg8::Gemm g{(const bf16_t*)(a->ws + WS_YG), (const bf16_t*)(a->ws + WS_WGLU), DM / 2, DM / 2, DM / 2}; pg8::GridOrder S; S.init(M / 256, 2 * DM / 256, G, bx);
#if (DUP_MASK >> 11) & 1
        { pg8::EpiGLU E2{(bf16_t*)(a->ws + WS_UA), 1.f}; pg8::gemm_phase<1>(lds, g, S, E2, wave); }
#endif
        pg8::EpiGLU E{HN, 1.f / (W8_GU_SCALE * Y8_SCALE)};
        pg8::gemm_phase<1>(lds, g, S, E, wave);
        SEAM(11);
    }
    if (IN(12)) { PH_BEGIN REP(12) {
        unsigned char* HN2 = a->ws + WS_HN2; const float* RW = a->in[I_ROUTER]; unsigned char* RT = a->ws + WS_ROUTE;
        f32x4 gv[8];
#pragma unroll
        for (int j = 0; j < 8; ++j) gv[j] = ((const f32x4*)a->in[I_MOENORM])[lane + 64 * j];
        int cnt[NEXP];
#pragma unroll
        for (int e = 0; e < NEXP; ++e) cnt[e] = 0;
        LAS float* RWt = (LAS float*)(lds + 8 * 9216);
        for (int i = tid; i < DM * NEXP / 4; i += 512) { const f32x4 w4 = ((const f32x4*)RW)[i]; const int col = i >> 1, e0 = (i & 1) * 4;
            RWt[(e0 + 0) * DM + col] = w4.x; RWt[(e0 + 1) * DM + col] = w4.y; RWt[(e0 + 2) * DM + col] = w4.z; RWt[(e0 + 3) * DM + col] = w4.w; }
        __syncthreads();
        u32x2 vnx[8];
        if (gw < M) { const u32x2* xr = (const u32x2*)(HN + (size_t)gw * DM) + lane;
#pragma unroll
            for (int j = 0; j < 8; ++j) vnx[j] = xr[64 * j]; }
        for (int m = gw; m < M; m += NGW) {
            f32x4 v[8]; float sq_ = 0.f;
#pragma unroll
            for (int j = 0; j < 8; ++j) { v[j] = (f32x4){bflo(vnx[j].x), bfhi(vnx[j].x), bflo(vnx[j].y), bfhi(vnx[j].y)}; sq_ += (v[j].x * v[j].x + v[j].y * v[j].y) + (v[j].z * v[j].z + v[j].w * v[j].w); }
            if (m + NGW < M) { const u32x2* xr = (const u32x2*)(HN + (size_t)(m + NGW) * DM) + lane;
#pragma unroll
                for (int j = 0; j < 8; ++j) vnx[j] = xr[64 * j]; }
            const float rstd = rsqrtf(wave_sum(sq_) * (1.f / DM) + EPS);
            float lg[NEXP];
#pragma unroll
            for (int e = 0; e < NEXP; ++e) lg[e] = 0.f;
            LAS float* tb = (LAS float*)(lds + wave * 9216);
#pragma unroll
            for (int j = 0; j < 8; ++j) {
                const float t0 = v[j].x * rstd * gv[j].x, t1 = v[j].y * rstd * gv[j].y, t2 = v[j].z * rstd * gv[j].z, t3 = v[j].w * rstd * gv[j].w;
                *(LAS f32x4*)(tb + ((lane >> 3) + 8 * j) * 36 + 4 * (lane & 7)) = (f32x4){t0, t1, t2, t3};
#pragma unroll
                for (int e = 0; e < NEXP; ++e) { const f32x4 w4 = *(const LAS f32x4*)(RWt + e * DM + 4 * lane + 256 * j);
                    lg[e] += t0 * w4.x; lg[e] += t1 * w4.y; lg[e] += t2 * w4.z; lg[e] += t3 * w4.w; }
            }
            { float x[32];
#pragma unroll
              for (int q = 0; q < 8; ++q) { const f32x4 t4 = *(const LAS f32x4*)(tb + lane * 36 + 4 * q); x[4 * q] = t4.x; x[4 * q + 1] = t4.y; x[4 * q + 2] = t4.z; x[4 * q + 3] = t4.w; }
              u32x6 pk; unsigned sb; quant_fp6_block(x, pk, sb);
              unsigned char* dst = HN2 + (size_t)m * DM + (lane >> 2) * 128 + (lane & 3) * 16;
              *(u32x4*)dst = (u32x4){pk[0], pk[1], pk[2], pk[3]}; *(u32x4*)(dst + 64) = (u32x4){pk[4], pk[5], sb, 0u}; }
#pragma unroll
            for (int e = 0; e < NEXP; ++e) lg[e] = wave_sum(lg[e]);
            int e1 = 0; float v1 = lg[0];
#pragma unroll
            for (int e = 1; e < NEXP; ++e) if (lg[e] > v1) { v1 = lg[e]; e1 = e; }
            int e2 = -1; float v2 = -3.0e38f;
#pragma unroll
            for (int e = 0; e < NEXP; ++e) if (e != e1 && lg[e] > v2) { v2 = lg[e]; e2 = e; }
            const float g1 = 1.f / (1.f + expf(v2 - v1)), g2 = 1.f - g1;
            if (lane == 0) { int* ri = (int*)(RT + (size_t)m * 24); ri[0] = e1; ri[1] = e2; ((float*)ri)[2] = g1; ((float*)ri)[3] = g2; }
#pragma unroll
            for (int e = 0; e < NEXP; ++e) cnt[e] += (e == e1 || e == e2) ? 1 : 0;
        }
        if (lane == 0 && rep_ == 0) {
#pragma unroll
            for (int e = 0; e < NEXP; ++e) if (cnt[e]) __hip_atomic_fetch_add(ctl + CW_ECNT + 64 * e, (unsigned)cnt[e], __ATOMIC_RELAXED, __HIP_MEMORY_SCOPE_AGENT);
        }
        }
        SEAM(12);
    }
    int ts[NEXP + 1];
    if (IN(13) || IN(14) || IN(15)) {
        ts[0] = 0;
#pragma unroll
        for (int e = 0; e < NEXP; ++e) { const unsigned c = __builtin_amdgcn_readfirstlane(__hip_atomic_load(ctl + CW_ECNT + 64 * e, __ATOMIC_RELAXED, __HIP_MEMORY_SCOPE_AGENT)); ts[e + 1] = ts[e] + (int)((c + 255u) >> 8); }
    }
    if (IN(13)) { PH_BEGIN
        unsigned char* RT = a->ws + WS_ROUTE; const unsigned char* HN2 = a->ws + WS_HN2; unsigned char* XP = a->ws + WS_XP;
        LAS int* slots = (LAS int*)lds;
        for (int blk = bx; blk < M / 128; blk += G) {
            if (wave < 2) {
                const int m = blk * 128 + wave * 64 + lane; int* ri = (int*)(RT + (size_t)m * 24);
                const int e1 = ri[0], e2 = ri[1]; int s1 = 0, s2 = 0;
#pragma unroll
                for (int e = 0; e < NEXP; ++e) {
                    const unsigned long long m1 = __ballot(e1 == e), m2 = __ballot(e2 == e);
                    const int c1 = __popcll(m1), c2 = __popcll(m2);
                    unsigned base = 0;
                    if (lane == 0 && (c1 + c2)) base = __hip_atomic_fetch_add(ctl + CW_EFILL + 64 * e, (unsigned)(c1 + c2), __ATOMIC_RELAXED, __HIP_MEMORY_SCOPE_AGENT);
                    base = (unsigned)__builtin_amdgcn_readfirstlane((int)base);
                    const unsigned long long lt = (1ull << lane) - 1ull;
                    if (e1 == e) s1 = ts[e] * 256 + (int)base + __popcll(m1 & lt);
                    if (e2 == e) s2 = ts[e] * 256 + (int)base + c1 + __popcll(m2 & lt);
                }
                ri[4] = s1; ri[5] = s2;
                slots[(wave * 64 + lane) * 2] = s1; slots[(wave * 64 + lane) * 2 + 1] = s2;
            }
            __syncthreads();
            { u32x4 xr[16][2];
#pragma unroll
              for (int i = 0; i < 16; ++i) { const u32x4* src = (const u32x4*)(HN2 + (size_t)(blk * 128 + wave * 16 + i) * DM) + lane; xr[i][0] = src[0]; xr[i][1] = src[64]; }
#pragma unroll
              for (int i = 0; i < 16; ++i) { const int tl = wave * 16 + i; const int s1 = slots[tl * 2], s2 = slots[tl * 2 + 1];
                u32x4* d1 = (u32x4*)(XP + (size_t)s1 * DM) + lane; u32x4* d2 = (u32x4*)(XP + (size_t)s2 * DM) + lane;
                d1[0] = xr[i][0]; d1[64] = xr[i][1]; d2[0] = xr[i][0]; d2[64] = xr[i][1]; } }
            __syncthreads();
        }
        SEAM(13);
    }
    if (IN(14)) { PH_BEGIN REP(14) {
        pg8::Gemm g{(const bf16_t*)(a->ws + WS_XP), (const bf16_t*)(a->ws + WS_WEGU), DM / 2, DM / 2, DM / 2};
        pg8::MoeOrder<56> S; S.go.init(ts[NEXP], 56, G, bx);
#pragma unroll
        for (int e = 0; e <= NEXP; ++e) S.ts[e] = ts[e];
        pg8::EpiSwiGLU8<56> E{a->ws + WS_ACTM, DFE, 1.f};
        pg8::gemm_phase<2>(lds, g, S, E, wave);
        }
        SEAM(14);
    }
    if (IN(15)) { PH_BEGIN REP(15) {
        const int TM = (G == 256 && ts[NEXP] > 256) ? 256 : ts[NEXP];
        { pg8::Gemm g{(const bf16_t*)(a->ws + WS_ACTM), (const bf16_t*)(a->ws + WS_WEDN), DFE / 2, DFE / 2, DFE / 2};
          pg8::MoeOrder<8> S; S.go.init(TM, 8, G, bx, 1);
#pragma unroll
          for (int e = 0; e <= NEXP; ++e) S.ts[e] = ts[e];
          pg8::EpiFp8Plain<8> E{a->ws + WS_YP, DM, YP8_SCALE / W8_DN_SCALE};
          pg8::gemm_phase<1>(lds, g, S, E, wave); }
        { const int nq = (ts[NEXP] - TM) * 32;
          const int qu = bx;
          if (qu < nq) {
            const int pm = TM + (qu >> 5), pnl = (qu >> 2) & 7, q = qu & 3; int e = 0;
#pragma unroll
            for (int k = 1; k < NEXP; ++k) e += (pm >= ts[k]) ? 1 : 0;
            pg8::Gemm g{(const bf16_t*)(a->ws + WS_ACTM + (size_t)q * (DFE / 4)), (const bf16_t*)(a->ws + WS_WEDN + (size_t)q * (DFE / 4)), DFE / 2, DFE / 2, DFE / 8};
            pg8::ListOrder S{pm, e * 8 + pnl, 1};
            pg8::EpiPartF32 E{(float*)(a->ws + WS_XP) + (size_t)q * 2048 * DM, TM, 1.f / W8_DN_SCALE};
            pg8::gemm_phase<1>(lds, g, S, E, wave);
          } }
        }
        SEAM(15);
    }
    if (IN(16)) { PH_BEGIN
        const unsigned char* RT = a->ws + WS_ROUTE; const bf16_t* YP = (const bf16_t*)(a->ws + WS_YP); const float* PART = (const float*)(a->ws + WS_XP); constexpr size_t PQ4 = (size_t)2048 * DM / 4;
        const unsigned tmo = __hip_atomic_load(ctl + CW_BAR + XB_TMO, __ATOMIC_RELAXED, __HIP_MEMORY_SCOPE_AGENT);
        int split0;
        { int tt = 0;
#pragma unroll
          for (int e = 0; e < NEXP; ++e) { const unsigned c = __builtin_amdgcn_readfirstlane(__hip_atomic_load(ctl + CW_ECNT + 64 * e, __ATOMIC_RELAXED, __HIP_MEMORY_SCOPE_AGENT)); tt += (int)((c + 255u) >> 8); }
          split0 = ((G == 256 && tt > 256) ? 256 : tt) * 256; }
        f32x4 gv[8];
#pragma unroll
        for (int j = 0; j < 8; ++j) gv[j] = ((const f32x4*)a->in[I_FINALNORM])[lane + 64 * j];
        for (int m = gw; m < M; m += NGW) {
            const int* ri = (const int*)(RT + (size_t)m * 24); const float g1 = ((const float*)ri)[2], g2 = ((const float*)ri)[3]; const int s1 = ri[4], s2 = ri[5];
            f32x4* hr = (f32x4*)(H + (size_t)m * DM) + lane; const u32x2* hb = (const u32x2*)(HN + (size_t)m * DM) + lane;
            f32x4 v[8], c1[8], c2[8]; float s = 0.f;
#define P16_ROW(S_, C_) do { if ((S_) < split0) { const unsigned* yp_ = (const unsigned*)((const unsigned char*)YP + (size_t)(S_) * DM) + lane; \
                _Pragma("unroll") for (int j = 0; j < 8; ++j) { const unsigned p = yp_[64 * j]; const auto lo_ = __builtin_amdgcn_cvt_pk_f32_fp8((int)p, false), hi_ = __builtin_amdgcn_cvt_pk_f32_fp8((int)p, true); \
                    C_[j] = (f32x4){lo_[0], lo_[1], hi_[0], hi_[1]} * (1.f / YP8_SCALE); } } \
              else { const f32x4* pp_ = (const f32x4*)(PART + (size_t)((S_) - split0) * DM) + lane; \
                _Pragma("unroll") for (int j = 0; j < 8; ++j) C_[j] = (pp_[64 * j] + pp_[64 * j + PQ4]) + (pp_[64 * j + 2 * PQ4] + pp_[64 * j + 3 * PQ4]); } } while (0)
            P16_ROW(s1, c1); P16_ROW(s2, c2);
#undef P16_ROW
#pragma unroll
            for (int j = 0; j < 8; ++j) { const u32x2 p = hb[64 * j]; const f32x4 x = (f32x4){bflo(p.x), bfhi(p.x), bflo(p.y), bfhi(p.y)};
                v[j] = x + c1[j] * g1 + c2[j] * g2;
                s += (v[j].x * v[j].x + v[j].y * v[j].y) + (v[j].z * v[j].z + v[j].w * v[j].w); }
            float rstd = rsqrtf(wave_sum(s) * (1.f / DM) + EPS);
            if (tmo) rstd = __builtin_nanf("");
#pragma unroll
            for (int j = 0; j < 8; ++j) hr[64 * j] = v[j] * rstd * gv[j];
        }
    }
#undef IN
#undef SEAM
}

extern "C" void kernel_launch(void* const* d_in, const int* in_sizes, int n_in, void* d_out, int out_size, void* d_ws, size_t ws_size, hipStream_t stream) {
    static int grid = 0;
    if (grid == 0) {
        if (n_in != 30 || out_size != M * DM || ws_size < WS_END) { fprintf(stderr, "kernel_launch: unexpected shapes: n_in %d out %d ws %zu (need %zu)\n", n_in, out_size, ws_size, (size_t)WS_END); grid = -1; return; }
        int dev = 0, cus = 0, per_cu = 0;
        if (hipGetDevice(&dev) != hipSuccess || hipDeviceGetAttribute(&cus, hipDeviceAttributeMultiprocessorCount, dev) != hipSuccess) { grid = -1; return; }
        if (hipFuncSetAttribute((const void*)fwd_kernel, hipFuncAttributeMaxDynamicSharedMemorySize, LDS_BYTES) != hipSuccess) { fprintf(stderr, "kernel_launch: hipFuncSetAttribute failed\n"); grid = -1; return; }
        if (hipOccupancyMaxActiveBlocksPerMultiprocessor(&per_cu, (const void*)fwd_kernel, 512, LDS_BYTES) != hipSuccess || per_cu < 1) fprintf(stderr, "kernel_launch: occupancy query reports %d\n", per_cu);
        (void)hipGetLastError();
        grid = cus;
    }
    if (grid < 0) return;
    (void)hipMemsetAsync((char*)d_ws + WS_CTL, 0, CTL_ZERO_BYTES, stream);
    Args a{};
    for (int i = 0; i < 30; ++i) a.in[i] = (const float*)d_in[i];
    a.out = (float*)d_out; a.ws = (unsigned char*)d_ws;
#if MK_MULTI
    for (int p = 0; p < NPHASE; ++p) { a.ph_lo = p; a.ph_hi = p + 1; hipLaunchKernelGGL(fwd_kernel, dim3(grid), dim3(512), LDS_BYTES, stream, a); }
#else
    a.ph_lo = 0; a.ph_hi = NPHASE;
    hipLaunchKernelGGL(fwd_kernel, dim3(grid), dim3(512), LDS_BYTES, stream, a);
#endif
}
```
